# Optimizing an MI355X kernel written in HIP

```python
import jax, jax.numpy as jnp
from jax import lax
import numpy as np


D_MODEL = 1024
BATCH = 16
SEQ = 2048
DEPTH = 2

GRID_W = 64
CTX_LEN = 256
EPS = 1e-6
N_REC = (DEPTH + 1) // 2
N_ATT = DEPTH // 2

A_HEADS = 4
A_KEY = 128
A_VAL = D_MODEL // (2 * A_HEADS)
A_QK = A_HEADS * A_KEY
A_V = A_HEADS * A_VAL
B_HEADS = 4
B_VAL = D_MODEL // (2 * B_HEADS)
B_KEY = B_VAL // 2
B_QK = B_HEADS * B_KEY
B_V = B_HEADS * B_VAL
B_GATE_RANK = 16
GLA_GATE_NORM = 16.0
LA_CHUNK = 32
REC_WIDTHS = (A_QK, A_QK, A_QK, A_V, A_V, B_QK, B_QK, B_V, B_GATE_RANK, B_GATE_RANK, B_V)
REC_IN = sum(REC_WIDTHS)
REC_OUT = A_V + B_V

C_HEAD_DIM = 64
C_HEADS = D_MODEL // C_HEAD_DIM
C_KV_HEADS = 4
C_Q = C_HEADS * C_HEAD_DIM
C_KV = C_KV_HEADS * C_HEAD_DIM
WINDOW = 128
ATT_BLOCK = 128
ROPE_BASE = 10000.0

FFN_HIDDEN = -(-(8 * D_MODEL) // (3 * 256)) * 256

kernel_name = 'hybrid_hgrn2_gla_swa_dit_block'


def rms_norm(x, g):
    xf = x.astype(jnp.float32)
    y = xf * lax.rsqrt(jnp.mean(jnp.square(xf), axis=-1, keepdims=True) + EPS)
    return (y * g.astype(jnp.float32)).astype(x.dtype)


def modulate(x, g, shift, scale):
    return rms_norm(x, g) * (1.0 + scale) + shift


def split_heads(a, n_heads):
    b_, l_, _ = a.shape
    return a.reshape(b_, l_, n_heads, -1).transpose(0, 2, 1, 3)


def merge_heads(a):
    b_, h_, l_, e_ = a.shape
    return a.transpose(0, 2, 1, 3).reshape(b_, l_, h_ * e_)


def swiglu(u, w_in, w_out):
    gt, up = jnp.split(u @ w_in, 2, axis=-1)
    return (jax.nn.silu(gt) * up) @ w_out


def hgrn_lower_bounds(lb_logits):
    p = jax.nn.softmax(lb_logits.astype(jnp.float32), axis=0)
    return jnp.cumsum(p, axis=0)[:-1]


def chunk_gla(q, k, v, g, s0):
    b_, h_, t_, _ = q.shape
    dv = v.shape[-1]
    n = t_ // LA_CHUNK

    def chunks(a):
        return a.reshape(b_, h_, n, LA_CHUNK, a.shape[-1]).astype(jnp.float32)

    qc, kc, vc, gc = chunks(q), chunks(k), chunks(v), chunks(g)
    bc = jnp.cumsum(gc, axis=3)
    b_last = bc[:, :, :, -1:, :]
    q_dec = qc * jnp.exp(bc)
    k_inv = kc * jnp.exp(-bc)
    k_end = kc * jnp.exp(b_last - bc)
    scores = jnp.einsum('bhnik,bhnjk->bhnij', q_dec, k_inv)
    causal_in_chunk = jnp.tril(jnp.ones((LA_CHUNK, LA_CHUNK), dtype=bool))
    scores = jnp.where(causal_in_chunk, scores, 0.0)
    o_intra = jnp.einsum('bhnij,bhnjv->bhniv', scores, vc)

    def step(s, xs):
        q_n, k_n, v_n, d_n = xs
        o_n = jnp.einsum('bhck,bhkv->bhcv', q_n, s)
        s = s * d_n[..., None] + jnp.einsum('bhck,bhcv->bhkv', k_n, v_n)
        return s, o_n

    xs = (jnp.moveaxis(q_dec, 2, 0), jnp.moveaxis(k_end, 2, 0), jnp.moveaxis(vc, 2, 0),
          jnp.moveaxis(jnp.exp(b_last[:, :, :, 0, :]), 2, 0))
    s_fin, o_inter = lax.scan(step, s0.astype(jnp.float32), xs)
    o = o_intra + jnp.moveaxis(o_inter, 0, 2)
    return o.reshape(b_, h_, t_, dv), s_fin


def prefix_scan(lat, ctx, reverse):
    if reverse:
        flip = lambda a: jnp.flip(a, axis=2)
    else:
        flip = lambda a: a
    q_c, k_c, v_c, g_c = (flip(a) for a in ctx)
    s0 = jnp.zeros((q_c.shape[0], q_c.shape[1], q_c.shape[3], v_c.shape[3]), jnp.float32)
    o_c, s_c = chunk_gla(q_c, k_c, v_c, g_c, s0)
    q, k, v, g = (flip(a) for a in lat)
    o, _ = chunk_gla(q, k, v, g, s_c)
    return flip(o), flip(o_c)


def rec_features(u, w_in, lb, w_g2, b_g2):
    offsets = np.cumsum(REC_WIDTHS)[:-1].tolist()
    (a_q, a_zf, a_zb, a_i, a_og, b_q, b_k, b_v, b_lf, b_lb, b_r) = jnp.split(u @ w_in, offsets, axis=-1)
    qa = split_heads(jax.nn.silu(a_q) * A_KEY ** -0.5, A_HEADS)
    va = split_heads(a_i, A_HEADS)
    a_dirs = []
    for d, z in enumerate((a_zf, a_zb)):
        f = lb[d] + (1.0 - lb[d]) * jax.nn.sigmoid(z.astype(jnp.float32))
        a_dirs.append((qa, split_heads(1.0 - f, A_HEADS), va, split_heads(jnp.log(f), A_HEADS)))
    qb = split_heads(b_q * B_KEY ** -0.5, B_HEADS)
    kb = split_heads(b_k, B_HEADS)
    vb = split_heads(b_v, B_HEADS)
    b_dirs = []
    for d, lr in enumerate((b_lf, b_lb)):
        gk = jax.nn.log_sigmoid((lr @ w_g2[d] + b_g2[d]).astype(jnp.float32)) / GLA_GATE_NORM
        b_dirs.append((qb, kb, vb, split_heads(gk, B_HEADS)))
    return a_dirs, b_dirs, a_og, b_r


def bidir_group(dirs_lat, dirs_ctx, gn, gate_lat, gate_ctx, need_ctx):
    o_lat, o_ctx = None, None
    for d in range(2):
        ol, oc = prefix_scan(dirs_lat[d], dirs_ctx[d], reverse=(d == 1))
        o_lat = ol if o_lat is None else o_lat + ol
        o_ctx = oc if o_ctx is None else o_ctx + oc
    y_lat = merge_heads(rms_norm(o_lat, gn)).astype(gate_lat.dtype) * jax.nn.silu(gate_lat)
    y_ctx = None
    if need_ctx:
        y_ctx = merge_heads(rms_norm(o_ctx, gn)).astype(gate_ctx.dtype) * jax.nn.silu(gate_ctx)
    return y_lat, y_ctx


def recurrent_mixer(u, u_c, w_in, w_out, lb, w_g2, b_g2, gn_a, gn_b, need_ctx):
    a_lat, b_lat, ag_lat, bg_lat = rec_features(u, w_in, lb, w_g2, b_g2)
    a_ctx, b_ctx, ag_ctx, bg_ctx = rec_features(u_c, w_in, lb, w_g2, b_g2)
    ya, ya_c = bidir_group(a_lat, a_ctx, gn_a, ag_lat, ag_ctx, need_ctx)
    yb, yb_c = bidir_group(b_lat, b_ctx, gn_b, bg_lat, bg_ctx, need_ctx)
    y = jnp.concatenate([ya, yb], axis=-1) @ w_out
    y_c = jnp.concatenate([ya_c, yb_c], axis=-1) @ w_out if need_ctx else None
    return y, y_c


def axial_rope_tables(t_len):
    n_rows = t_len // GRID_W
    row = jnp.repeat(jnp.arange(n_rows), GRID_W).astype(jnp.float32)
    col = jnp.tile(jnp.arange(GRID_W), n_rows).astype(jnp.float32)
    half = C_HEAD_DIM // 2
    inv = ROPE_BASE ** (-jnp.arange(0, half, 2, dtype=jnp.float32) / half)
    ang = jnp.concatenate([row[:, None] * inv, col[:, None] * inv], axis=-1)
    return jnp.cos(ang), jnp.sin(ang)


def apply_rope(x, cos, sin):
    xf = x.astype(jnp.float32).reshape(x.shape[:-1] + (-1, 2))
    x0, x1 = xf[..., 0], xf[..., 1]
    y = jnp.stack([x0 * cos - x1 * sin, x0 * sin + x1 * cos], axis=-1)
    return y.reshape(x.shape).astype(x.dtype)


def windowed_sink_attention(q, k, v, k_c, v_c, sink):
    b_, hq, t_, e_ = q.shape
    g_ = hq // C_KV_HEADS
    nb = t_ // ATT_BLOCK
    lc = k_c.shape[2]
    scale = e_ ** -0.5
    qb = q.reshape(b_, C_KV_HEADS, g_, nb, ATT_BLOCK, e_)

    def band(a):
        ap = jnp.pad(a, ((0, 0), (0, 0), (ATT_BLOCK, ATT_BLOCK), (0, 0)))
        ap = ap.reshape(b_, C_KV_HEADS, nb + 2, ATT_BLOCK, e_)
        return jnp.concatenate([ap[:, :, :-2], ap[:, :, 1:-1], ap[:, :, 2:]], axis=3)

    kb, vb = band(k), band(v)
    qi = jnp.arange(ATT_BLOCK)[:, None]
    kj = jnp.arange(3 * ATT_BLOCK)[None, :] - ATT_BLOCK
    rel_ok = jnp.abs(kj - qi) <= WINDOW
    key_pos = jnp.arange(nb)[:, None] * ATT_BLOCK + kj
    in_range = (key_pos >= 0) & (key_pos < t_)
    mask = rel_ok[None, :, :] & in_range[:, None, :]
    sink_f = sink.astype(jnp.float32).reshape(1, C_KV_HEADS, g_, 1, 1)
    k_cf = k_c.astype(jnp.float32)
    v_cf = v_c.astype(jnp.float32)

    def block_fn(args):
        q_n, k_n, v_n, m_n = args
        q_n = q_n.astype(jnp.float32) * scale
        s_lat = jnp.einsum('bkgie,bkje->bkgij', q_n, k_n.astype(jnp.float32))
        s_lat = jnp.where(m_n, s_lat, -1e30)
        s_ctx = jnp.einsum('bkgie,bkje->bkgij', q_n, k_cf)
        s_snk = jnp.broadcast_to(sink_f, s_lat.shape[:-1] + (1,))
        p = jax.nn.softmax(jnp.concatenate([s_lat, s_ctx, s_snk], axis=-1), axis=-1)
        p_lat = p[..., :3 * ATT_BLOCK]
        p_ctx = p[..., 3 * ATT_BLOCK:3 * ATT_BLOCK + lc]
        return (jnp.einsum('bkgij,bkje->bkgie', p_lat, v_n.astype(jnp.float32))
                + jnp.einsum('bkgij,bkje->bkgie', p_ctx, v_cf))

    out = lax.map(block_fn, (jnp.moveaxis(qb, 3, 0), jnp.moveaxis(kb, 2, 0), jnp.moveaxis(vb, 2, 0), mask))
    out = out.transpose(1, 2, 3, 0, 4, 5).reshape(b_, hq, t_, e_)
    return out.astype(q.dtype)


def context_sink_attention(q, k, v, sink):
    b_, hq, l_, e_ = q.shape
    g_ = hq // C_KV_HEADS
    qg = q.reshape(b_, C_KV_HEADS, g_, l_, e_).astype(jnp.float32) * e_ ** -0.5
    s = jnp.einsum('bkgie,bkje->bkgij', qg, k.astype(jnp.float32))
    s_snk = jnp.broadcast_to(sink.astype(jnp.float32).reshape(1, C_KV_HEADS, g_, 1, 1), s.shape[:-1] + (1,))
    p = jax.nn.softmax(jnp.concatenate([s, s_snk], axis=-1), axis=-1)[..., :-1]
    o = jnp.einsum('bkgij,bkje->bkgie', p, v.astype(jnp.float32))
    return o.reshape(b_, hq, l_, e_).astype(q.dtype)


def attention_mixer(u, u_c, w_qkv, w_o, sink, cos, sin, need_ctx):
    q, k, v = jnp.split(u @ w_qkv, [C_Q, C_Q + C_KV], axis=-1)
    q = apply_rope(split_heads(q, C_HEADS), cos, sin)
    k = apply_rope(split_heads(k, C_KV_HEADS), cos, sin)
    v = split_heads(v, C_KV_HEADS)
    k_c, v_c = jnp.split(u_c @ w_qkv[:, C_Q:], 2, axis=-1)
    k_c = split_heads(k_c, C_KV_HEADS)
    v_c = split_heads(v_c, C_KV_HEADS)
    y = merge_heads(windowed_sink_attention(q, k, v, k_c, v_c, sink)) @ w_o
    y_c = None
    if need_ctx:
        q_c = split_heads(u_c @ w_qkv[:, :C_Q], C_HEADS)
        y_c = merge_heads(context_sink_attention(q_c, k_c, v_c, sink)) @ w_o
    return y, y_c


def setup_inputs(seed: int = 0) -> dict:
    key = jax.random.key(seed)
    ks = jax.random.split(key, 19)

    def nrm(k, shape, fan_in, gain=1.0):
        return jax.random.normal(k, shape, jnp.float32) * (gain * fan_in ** -0.5)

    return {
        'x': jax.random.normal(ks[0], (BATCH, SEQ, D_MODEL), jnp.float32),
        'c': jax.random.normal(ks[1], (BATCH, D_MODEL), jnp.float32),
        'ctx': jax.random.normal(ks[2], (BATCH, CTX_LEN, D_MODEL), jnp.float32),
        'c_ctx': jax.random.normal(ks[3], (D_MODEL,), jnp.float32),
        'ada_w': nrm(ks[4], (DEPTH, D_MODEL, 6 * D_MODEL), D_MODEL, 0.5),
        'ada_b': 0.02 * jax.random.normal(ks[5], (DEPTH, 6 * D_MODEL), jnp.float32),
        'norm_g': 1.0 + 0.05 * jax.random.normal(ks[6], (DEPTH, 4, D_MODEL), jnp.float32),
        'rec_w_in': nrm(ks[7], (N_REC, D_MODEL, REC_IN), D_MODEL),
        'rec_w_out': nrm(ks[8], (N_REC, REC_OUT, D_MODEL), REC_OUT),
        'rec_lb_logits': 0.5 * jax.random.normal(ks[9], (N_REC + 1, 2, A_QK), jnp.float32),
        'rec_w_g2': nrm(ks[10], (N_REC, 2, B_GATE_RANK, B_QK), B_GATE_RANK),
        'rec_b_g2': 0.1 * jax.random.normal(ks[11], (N_REC, 2, B_QK), jnp.float32),
        'rec_gn_a': 1.0 + 0.05 * jax.random.normal(ks[12], (N_REC, A_VAL), jnp.float32),
        'rec_gn_b': 1.0 + 0.05 * jax.random.normal(ks[13], (N_REC, B_VAL), jnp.float32),
        'att_w_qkv': nrm(ks[14], (N_ATT, D_MODEL, C_Q + 2 * C_KV), D_MODEL),
        'att_w_o': nrm(ks[15], (N_ATT, C_Q, D_MODEL), C_Q),
        'att_sink': 0.5 * jax.random.normal(ks[16], (N_ATT, C_HEADS), jnp.float32),
        'ffn_w_in': nrm(ks[17], (DEPTH, D_MODEL, 2 * FFN_HIDDEN), D_MODEL),
        'ffn_w_out': nrm(ks[18], (DEPTH, FFN_HIDDEN, D_MODEL), FFN_HIDDEN),
    }


def reference(x, c, ctx, c_ctx, ada_w, ada_b, norm_g, rec_w_in, rec_w_out, rec_lb_logits,
              rec_w_g2, rec_b_g2, rec_gn_a, rec_gn_b, att_w_qkv, att_w_o, att_sink,
              ffn_w_in, ffn_w_out):
    x_lat, x_ctx = x, ctx
    lbs = hgrn_lower_bounds(rec_lb_logits)
    cos, sin = axial_rope_tables(x.shape[1])
    s_lat = jax.nn.silu(c)
    s_ctx = jax.nn.silu(c_ctx)
    for l in range(DEPTH):
        need_ctx = l < DEPTH - 1
        ng = norm_g[l]
        ml = [m[:, None, :] for m in jnp.split(s_lat @ ada_w[l] + ada_b[l], 6, axis=-1)]
        mc = jnp.split(s_ctx @ ada_w[l] + ada_b[l], 6, axis=-1)
        u_lat = modulate(x_lat, ng[0], ml[0], ml[1])
        u_ctx = modulate(x_ctx, ng[0], mc[0], mc[1])
        j = l // 2
        if l % 2 == 0:
            y_lat, y_ctx = recurrent_mixer(u_lat, u_ctx, rec_w_in[j], rec_w_out[j], lbs[j],
                                           rec_w_g2[j], rec_b_g2[j], rec_gn_a[j], rec_gn_b[j], need_ctx)
        else:
            y_lat, y_ctx = attention_mixer(u_lat, u_ctx, att_w_qkv[j], att_w_o[j], att_sink[j],
                                           cos, sin, need_ctx)
        x_lat = x_lat + ml[2] * rms_norm(y_lat, ng[1])
        h_lat = swiglu(modulate(x_lat, ng[2], ml[3], ml[4]), ffn_w_in[l], ffn_w_out[l])
        x_lat = x_lat + ml[5] * rms_norm(h_lat, ng[3])
        if need_ctx:
            x_ctx = x_ctx + mc[2] * rms_norm(y_ctx, ng[1])
            h_ctx = swiglu(modulate(x_ctx, ng[2], mc[3], mc[4]), ffn_w_in[l], ffn_w_out[l])
            x_ctx = x_ctx + mc[5] * rms_norm(h_ctx, ng[3])
    return x_lat
```

```cpp
#include <hip/hip_runtime.h>
#include <cstdint>
#include <cstdio>

namespace pg8 {
#define PG8_LAS __attribute__((address_space(3)))
typedef unsigned short bf16_t;
typedef short bf16x8 __attribute__((ext_vector_type(8)));
typedef float f32x4 __attribute__((ext_vector_type(4)));
typedef unsigned u32x4 __attribute__((ext_vector_type(4)));
constexpr int BM = 256, BK = 64, HALF = 128, HTB = HALF * BK * 2  , STAGE_BYTES = 8 * HTB, NXCD = 8, WGM = 8;

__host__ __device__ __forceinline__ int lds_byte(int r, int c) { const int st = (r >> 4) * 2 + (c >> 5), rr = r & 15, cc = c & 31, ob = rr * 64 + cc * 2; return st * 1024 + (ob ^ (((ob >> 9) & 1) << 5)); }
__host__ __device__ __forceinline__ void stage_rc(int b, int& R, int& C) { const int st = b / 1024, sb = b % 1024, swz = sb ^ (((sb >> 9) & 1) << 5); R = (st >> 1) * 16 + swz / 64; C = (st & 1) * 32 + (swz % 64) / 2; }
__host__ __device__ __forceinline__ int perm32(int rho) { const int n = rho >> 4, i = rho & 15; return 8 * (i >> 2) + 4 * n + (i & 3); }

struct Unit { int pm, pn; };
struct Gemm { const bf16_t* A; const bf16_t* Bt; int M, N, K, ld; };

struct StaticOrder {
    int nM, nN, nwg, G, c;
    __host__ __device__ void init(int M, int N, int G_, int c_) { nM = M / BM; nN = N / BM; nwg = nM * nN; G = G_; c = c_; }
    __host__ __device__ bool next(int i, Unit& u) const {
        const long L = (long)i * G + c; if (L >= nwg) return false;
        int wgid = (int)L; { const int q = nwg / NXCD, r = nwg % NXCD, xcd = wgid % NXCD, off = wgid / NXCD; wgid = (xcd < r ? xcd * (q + 1) : r * (q + 1) + (xcd - r) * q) + off; }
        const int nig = WGM * nN, gid = wgid / nig, fm = gid * WGM, gsz = (nM - fm) < WGM ? (nM - fm) : WGM;
        u.pm = fm + ((wgid % nig) % gsz); u.pn = (wgid % nig) / gsz; return true;
    }
    __device__ __forceinline__ void a_ready(const Unit&) const {}
    __device__ __forceinline__ void done(const Unit&) const {}
};


__device__ __forceinline__ unsigned cvt_pk_bf16(float lo, float hi) { unsigned r; asm volatile("v_cvt_pk_bf16_f32 %0, %1, %2" : "=v"(r) : "v"(lo), "v"(hi)); return r; }
typedef float f32x2 __attribute__((ext_vector_type(2)));

struct EpiBf16 {
    static constexpr bool PERM = true, AFTER_DRAIN = false;
    bf16_t* O; int ldc; int split_cols; size_t split_stride;
    __device__ __forceinline__ void operator()(const f32x4 (&acc)[2][2][4][2], const Unit& u, int wr, int wc, int fr, int fq) const {
        const int row0 = u.pm * BM + wr * 64 + fr; int colt = u.pn * BM; bf16_t* base = O;
        if (split_cols) { const int t = colt / split_cols; base += (size_t)t * split_stride; colt -= t * split_cols; }
        const int col0 = colt + wc * 32 + 8 * fq;
#pragma unroll
        for (int ai = 0; ai < 2; ++ai)
#pragma unroll
            for (int m = 0; m < 4; ++m) { bf16_t* rowp = base + (size_t)(row0 + ai * HALF + m * 16) * ldc + col0;
#pragma unroll
                for (int bj = 0; bj < 2; ++bj) { const f32x4 v0 = acc[ai][bj][m][0], v1 = acc[ai][bj][m][1];
                    u32x4 w; w.x = cvt_pk_bf16(v0[0], v0[1]); w.y = cvt_pk_bf16(v0[2], v0[3]); w.z = cvt_pk_bf16(v1[0], v1[1]); w.w = cvt_pk_bf16(v1[2], v1[3]);
                    *(u32x4*)(rowp + bj * HALF) = w; } }
    }
};
__device__ __forceinline__ float silu_fast(float x) { return x * __builtin_amdgcn_rcpf(1.f + __builtin_amdgcn_exp2f(-1.4426950408889634f * x)); }
struct EpiSwiglu {
    static constexpr bool PERM = true, AFTER_DRAIN = false;
    bf16_t* H; int ldh; int pad;
    __device__ __forceinline__ void operator()(const f32x4 (&acc)[2][2][4][2], const Unit& u, int wr, int wc, int fr, int fq) const {
        const int row0 = u.pm * BM + wr * 64 + fr; const int col0 = u.pn * HALF + wc * 32 + 8 * fq;
#pragma unroll
        for (int ai = 0; ai < 2; ++ai)
#pragma unroll
            for (int m = 0; m < 4; ++m) { bf16_t* rowp = H + (size_t)(row0 + ai * HALF + m * 16) * ldh + col0;
                float o[8];
#pragma unroll
                for (int n = 0; n < 2; ++n)
#pragma unroll
                    for (int j = 0; j < 4; ++j) { const float g2 = acc[ai][0][m][n][j]; o[4 * n + j] = (g2 * __builtin_amdgcn_rcpf(1.f + __builtin_amdgcn_exp2f(-g2))) * acc[ai][1][m][n][j]; }
                u32x4 w; w.x = cvt_pk_bf16(o[0], o[1]); w.y = cvt_pk_bf16(o[2], o[3]); w.z = cvt_pk_bf16(o[4], o[5]); w.w = cvt_pk_bf16(o[6], o[7]);
                *(u32x4*)rowp = w; }
    }
};
struct OneUnit { __host__ __device__ bool next(int i, Unit& u) const { if (i > 0) return false; u.pm = 0; u.pn = 0; return true; }
    __device__ __forceinline__ void a_ready(const Unit&) const {} __device__ __forceinline__ void done(const Unit&) const {} };
struct EpiRecIn {
    static constexpr bool PERM = true, AFTER_DRAIN = false;
    bf16_t* O; int ldc; int pad; const float* lb; const float* bg;
    __device__ __forceinline__ void operator()(const f32x4 (&acc)[2][2][4][2], const Unit& u, int wr, int wc, int fr, int fq) const {
        const int row0 = u.pm * BM + wr * 64 + fr; const int colt = u.pn * BM; const int col0 = colt + wc * 32 + 8 * fq;
        const int mode = u.pn < 2 ? 1 : (u.pn < 6 ? 2 : 0);
        float cst[2][8];
#pragma unroll
        for (int bj = 0; bj < 2; ++bj)
#pragma unroll
            for (int j = 0; j < 8; ++j) cst[bj][j] = 0.f;
        if (mode == 2) {
#pragma unroll
            for (int bj = 0; bj < 2; ++bj) { const f32x4 a = *(const f32x4*)(lb + col0 + bj * HALF - 512), b = *(const f32x4*)(lb + col0 + bj * HALF - 512 + 4);
                cst[bj][0] = 1.f - a[0]; cst[bj][1] = 1.f - a[1]; cst[bj][2] = 1.f - a[2]; cst[bj][3] = 1.f - a[3]; cst[bj][4] = 1.f - b[0]; cst[bj][5] = 1.f - b[1]; cst[bj][6] = 1.f - b[2]; cst[bj][7] = 1.f - b[3]; } }
        else if (mode == 3) {
#pragma unroll
            for (int bj = 0; bj < 2; ++bj) { const f32x4 a = *(const f32x4*)(bg + col0 + bj * HALF - 3584), b = *(const f32x4*)(bg + col0 + bj * HALF - 3584 + 4);
                cst[bj][0] = a[0]; cst[bj][1] = a[1]; cst[bj][2] = a[2]; cst[bj][3] = a[3]; cst[bj][4] = b[0]; cst[bj][5] = b[1]; cst[bj][6] = b[2]; cst[bj][7] = b[3]; } }
#pragma unroll
        for (int ai = 0; ai < 2; ++ai)
#pragma unroll
            for (int m = 0; m < 4; ++m) { bf16_t* rowp = O + (size_t)(row0 + ai * HALF + m * 16) * ldc + col0;
#pragma unroll
                for (int bj = 0; bj < 2; ++bj) { float v[8];
#pragma unroll
                    for (int j = 0; j < 4; ++j) { v[j] = acc[ai][bj][m][0][j]; v[4 + j] = acc[ai][bj][m][1][j]; }
                    if (mode == 1) {
#pragma unroll
                        for (int j = 0; j < 8; ++j) v[j] = silu_fast(v[j]) * 0.08838834764831845f; }
                    else if (mode == 2) {
#pragma unroll
                        for (int j = 0; j < 8; ++j) v[j] = cst[bj][j] * __builtin_amdgcn_rcpf(1.f + __builtin_amdgcn_exp2f(1.4426950408889634f * v[j])); }
                    else if (mode == 3) {
#pragma unroll
                        for (int j = 0; j < 8; ++j) { const float x = v[j] + cst[bj][j]; const float e = __builtin_amdgcn_exp2f(-1.4426950408889634f * __builtin_fabsf(x));
                            v[j] = (__builtin_fminf(x, 0.f) * 1.4426950408889634f - __builtin_amdgcn_logf(1.f + e)) * (1.f / 16.f); } }
                    u32x4 w; w.x = cvt_pk_bf16(v[0], v[1]); w.y = cvt_pk_bf16(v[2], v[3]); w.z = cvt_pk_bf16(v[4], v[5]); w.w = cvt_pk_bf16(v[6], v[7]);
                    *(u32x4*)(rowp + bj * HALF) = w; } }
    }
};
struct EpiQKV {
    static constexpr bool PERM = true, AFTER_DRAIN = false;
    bf16_t *Q, *Kd, *V; const float* rope;
    __device__ __forceinline__ void operator()(const f32x4 (&acc)[2][2][4][2], const Unit& u, int wr, int wc, int fr, int fq) const {
        const int row0 = u.pm * BM + wr * 64 + fr; const int i0 = (wc & 1) * 16 + 4 * fq;
#pragma unroll
        for (int ai = 0; ai < 2; ++ai)
#pragma unroll
            for (int m = 0; m < 4; ++m) { const int r = row0 + ai * HALF + m * 16; const int t = r & 2047;
                f32x4 cs = (f32x4){1.f, 1.f, 1.f, 1.f}, sn = (f32x4){0.f, 0.f, 0.f, 0.f};
                if (u.pn < 5) { cs = *(const f32x4*)(rope + t * 32 + i0); sn = *(const f32x4*)(rope + 2048 * 32 + t * 32 + i0); }
#pragma unroll
                for (int bj = 0; bj < 2; ++bj) { const f32x4 v0 = acc[ai][bj][m][0], v1 = acc[ai][bj][m][1]; const int c = u.pn * BM + bj * HALF + wc * 32 + 8 * fq;
                    float o[8];
                    o[0] = v0[0] * cs[0] - v0[1] * sn[0]; o[1] = v0[0] * sn[0] + v0[1] * cs[0]; o[2] = v0[2] * cs[1] - v0[3] * sn[1]; o[3] = v0[2] * sn[1] + v0[3] * cs[1];
                    o[4] = v1[0] * cs[2] - v1[1] * sn[2]; o[5] = v1[0] * sn[2] + v1[1] * cs[2]; o[6] = v1[2] * cs[3] - v1[3] * sn[3]; o[7] = v1[2] * sn[3] + v1[3] * cs[3];
                    const float sc = u.pn < 4 ? 0.125f * 1.4426950408889634f : 1.f;
                    u32x4 w; w.x = cvt_pk_bf16(o[0] * sc, o[1] * sc); w.y = cvt_pk_bf16(o[2] * sc, o[3] * sc); w.z = cvt_pk_bf16(o[4] * sc, o[5] * sc); w.w = cvt_pk_bf16(o[6] * sc, o[7] * sc);
                    bf16_t* dst = u.pn < 4 ? Q + (size_t)r * 1024 + c : (u.pn == 4 ? Kd + (size_t)r * 256 + (c - 1024) : V + (size_t)r * 256 + (c - 1280));
                    *(u32x4*)dst = w; } }
    }
};
extern __shared__ __attribute__((aligned(16))) unsigned char lds_raw[];
constexpr int LDS_BYTES_ = 147456, LDS_WID_TAB = LDS_BYTES_ - 128;
__device__ __forceinline__ int hwslot_() { return (int)__builtin_amdgcn_s_getreg(4 | (0 << 6) | (5 << 11)); }
__device__ __forceinline__ int tid_hw() {
    const int slot = hwslot_();
    const int wv = __builtin_amdgcn_readfirstlane((int)((volatile __attribute__((address_space(3))) unsigned char*)lds_raw)[LDS_WID_TAB + slot]);
    int l; asm volatile("v_mbcnt_lo_u32_b32 %0, -1, 0\n\tv_mbcnt_hi_u32_b32 %0, -1, %0" : "=v"(l));
    return wv * 64 + l;
}
template <class Epi, class Sched, bool ALIGN_EPI = false, bool SP2 = false>
__device__ __forceinline__ void gemm_phase(PG8_LAS unsigned char* lds, const Gemm g, const Sched& S, const Epi& E) {
    int tid = tid_hw(); const int wid = __builtin_amdgcn_readfirstlane(tid >> 6), lane = tid & 63, wr = wid >> 2, wc = wid & 3, fr = lane & 15, fq = lane >> 4;
    const int K = g.ld, nt = g.K / BK;
    unsigned voffA[2], voffB[2];
#pragma unroll
    for (int i = 0; i < 2; ++i) { int R, C; stage_rc(tid * 16 + i * 8192, R, C); const int Rb = Epi::PERM ? ((R & ~31) + perm32(R & 31)) : R;
        voffA[i] = (unsigned)(R * K + C) * 2u; voffB[i] = (unsigned)(Rb * K + C) * 2u; }
    const size_t kstep = (size_t)(BK * 2);
    const size_t hstep = (size_t)HALF * K * 2;
    const size_t tstep = 2 * hstep;
    const unsigned ldsw = (unsigned)wid * 1024u;
    const int aoff = lds_byte(wr * 64 + fr, fq * 8), boff = lds_byte(wc * 32 + fr, fq * 8);
#define PG8_SA(b, h) (((b) * 2 + (h)) * HTB)
#define PG8_SB(b, h) ((4 + (b) * 2 + (h)) * HTB)
#define PG8_STAGE(bufoff, gbase, voff) do { _Pragma("unroll") for (int _i = 0; _i < 2; ++_i) \
        __builtin_amdgcn_global_load_lds((const unsigned*)((const char*)(gbase) + (voff)[_i]), (PG8_LAS unsigned*)(lds + (bufoff) + ldsw + _i * 8192), 16, 0, 0); } while (0)
#define PG8_LDA(dst, b, h) do { _Pragma("unroll") for (int m = 0; m < 4; ++m) _Pragma("unroll") for (int k = 0; k < 2; ++k) dst[m][k] = *(const PG8_LAS bf16x8*)(lds + PG8_SA(b, h) + aoff + m * 2048 + k * 1024); } while (0)
#define PG8_LDB(dst, b, h) do { _Pragma("unroll") for (int n = 0; n < 2; ++n) _Pragma("unroll") for (int k = 0; k < 2; ++k) dst[n][k] = *(const PG8_LAS bf16x8*)(lds + PG8_SB(b, h) + boff + n * 2048 + k * 1024); } while (0)
#define PG8_MMA(ai, bj, At, Bt) do { __builtin_amdgcn_s_setprio(1); _Pragma("unroll") for (int m = 0; m < 4; ++m) _Pragma("unroll") for (int n = 0; n < 2; ++n) _Pragma("unroll") for (int k = 0; k < 2; ++k) \
        acc[ai][bj][m][n] = __builtin_amdgcn_mfma_f32_16x16x32_bf16(Bt[n][k], At[m][k], acc[ai][bj][m][n], 0, 0, 0); __builtin_amdgcn_s_setprio(0); } while (0)
#define PG8_MMA0(ai, bj, At, Bt) do { __builtin_amdgcn_s_setprio(1); _Pragma("unroll") for (int m = 0; m < 4; ++m) _Pragma("unroll") for (int n = 0; n < 2; ++n) { \
        acc[ai][bj][m][n] = __builtin_amdgcn_mfma_f32_16x16x32_bf16(Bt[n][0], At[m][0], (f32x4){0.f, 0.f, 0.f, 0.f}, 0, 0, 0); \
        acc[ai][bj][m][n] = __builtin_amdgcn_mfma_f32_16x16x32_bf16(Bt[n][1], At[m][1], acc[ai][bj][m][n], 0, 0, 0); } __builtin_amdgcn_s_setprio(0); } while (0)
#define PG8_WAIT_V(n) asm volatile("s_waitcnt vmcnt(" #n ")" ::: "memory")
#define PG8_WAIT_L(n) asm volatile("s_waitcnt lgkmcnt(" #n ")" ::: "memory")
#define PG8_BAR __builtin_amdgcn_s_barrier()
#define PG8_SCHED __builtin_amdgcn_sched_barrier(0)
    Unit cur, nxt; int ui = 0;
    if (!S.next(0, cur)) return;
    f32x4 acc[2][2][4][2];
#pragma unroll
    for (int a = 0; a < 2; ++a)
#pragma unroll
        for (int b = 0; b < 2; ++b)
#pragma unroll
            for (int m = 0; m < 4; ++m)
#pragma unroll
                for (int n = 0; n < 2; ++n) acc[a][b][m][n] = (f32x4){0.f, 0.f, 0.f, 0.f};
    bf16x8 At[4][2], B0[2][2], B1[2][2];
    const char* cA = (const char*)g.A + (size_t)cur.pm * tstep; const char* cB = (const char*)g.Bt + (size_t)cur.pn * tstep;
    S.a_ready(cur);
    if constexpr (SP2) {
        PG8_STAGE(PG8_SB(0, 0), cB, voffB); PG8_STAGE(PG8_SB(0, 1), cB + hstep, voffB); PG8_STAGE(PG8_SA(0, 0), cA, voffA); PG8_STAGE(PG8_SA(0, 1), cA + hstep, voffA);
        if (wr == 1) PG8_BAR;
        PG8_WAIT_V(2); PG8_BAR;
        PG8_STAGE(PG8_SB(1, 0), cB + kstep, voffB); PG8_STAGE(PG8_SA(1, 0), cA + kstep, voffA); PG8_STAGE(PG8_SB(1, 1), cB + hstep + kstep, voffB);
        PG8_WAIT_V(6); PG8_BAR;
    } else {
        PG8_STAGE(PG8_SB(0, 0), cB, voffB); PG8_STAGE(PG8_SA(0, 0), cA, voffA); PG8_STAGE(PG8_SB(0, 1), cB + hstep, voffB); PG8_STAGE(PG8_SA(0, 1), cA + hstep, voffA);
        if (wr == 1) PG8_BAR;
        PG8_WAIT_V(4); PG8_BAR;
        PG8_STAGE(PG8_SB(1, 0), cB + kstep, voffB); PG8_STAGE(PG8_SA(1, 0), cA + kstep, voffA); PG8_STAGE(PG8_SB(1, 1), cB + hstep + kstep, voffB);
        PG8_WAIT_V(6); PG8_BAR;
    }
    for (;;) {
        const bool has_next = S.next(ui + 1, nxt);
        const char* nA = has_next ? (const char*)g.A + (size_t)nxt.pm * tstep : cA; const char* nB = has_next ? (const char*)g.Bt + (size_t)nxt.pn * tstep : cB;
        if constexpr (SP2) {
            const char* a1 = cA + kstep; const char* a2 = cA + 2 * kstep; const char* b2 = cB + 2 * kstep; const char* a3 = a2 + kstep; const char* b3 = b2 + kstep;
            PG8_LDB(B0, 0, 0); PG8_LDB(B1, 0, 1); PG8_SCHED; PG8_LDA(At, 0, 0); PG8_STAGE(PG8_SA(1, 1), a1 + hstep, voffA);
            PG8_WAIT_V(8); PG8_WAIT_L(0); PG8_BAR; PG8_MMA0(0, 0, At, B0); PG8_MMA0(0, 1, At, B1); PG8_BAR; PG8_SCHED;
            PG8_LDA(At, 0, 1); PG8_STAGE(PG8_SB(0, 0), b2, voffB); PG8_STAGE(PG8_SB(0, 1), b2 + hstep, voffB); PG8_STAGE(PG8_SA(0, 0), a2, voffA);
            PG8_WAIT_V(8); PG8_WAIT_L(0); PG8_BAR; PG8_MMA0(1, 0, At, B0); PG8_MMA0(1, 1, At, B1); PG8_BAR; PG8_SCHED;
            PG8_LDB(B0, 1, 0); PG8_LDB(B1, 1, 1); PG8_SCHED; PG8_LDA(At, 1, 0); PG8_STAGE(PG8_SA(0, 1), a2 + hstep, voffA);
            PG8_WAIT_V(8); PG8_WAIT_L(0); PG8_BAR; PG8_MMA(0, 0, At, B0); PG8_MMA(0, 1, At, B1); PG8_BAR; PG8_SCHED;
            PG8_LDA(At, 1, 1); PG8_STAGE(PG8_SB(1, 0), b3, voffB); PG8_STAGE(PG8_SB(1, 1), b3 + hstep, voffB); PG8_STAGE(PG8_SA(1, 0), a3, voffA);
            PG8_WAIT_V(8); PG8_WAIT_L(0); PG8_BAR; PG8_MMA(1, 0, At, B0); PG8_MMA(1, 1, At, B1); PG8_BAR; PG8_SCHED;
        }
        for (int t = SP2 ? 2 : 0; t < nt; t += 2) {
            const bool last = (t == nt - 2);
            const char* a1 = cA + (size_t)(t + 1) * kstep;
            const char* a2 = last ? nA : cA + (size_t)(t + 2) * kstep; const char* b2 = last ? nB : cB + (size_t)(t + 2) * kstep;
            const char* a3 = a2 + kstep; const char* b3 = b2 + kstep;
            if (last && has_next) S.a_ready(nxt);
            if constexpr (SP2) {
            PG8_LDB(B0, 0, 0); PG8_LDB(B1, 0, 1); PG8_SCHED; PG8_LDA(At, 0, 0); PG8_STAGE(PG8_SA(1, 1), a1 + hstep, voffA);
            PG8_WAIT_V(8); PG8_WAIT_L(0); PG8_BAR; PG8_MMA(0, 0, At, B0); PG8_MMA(0, 1, At, B1); PG8_BAR; PG8_SCHED;
            PG8_LDA(At, 0, 1); PG8_STAGE(PG8_SB(0, 0), b2, voffB); PG8_STAGE(PG8_SB(0, 1), b2 + hstep, voffB); PG8_STAGE(PG8_SA(0, 0), a2, voffA);
            PG8_WAIT_V(8); PG8_WAIT_L(0); PG8_BAR; PG8_MMA(1, 0, At, B0); PG8_MMA(1, 1, At, B1); PG8_BAR; PG8_SCHED;
            PG8_LDB(B0, 1, 0); PG8_LDB(B1, 1, 1); PG8_SCHED; PG8_LDA(At, 1, 0); PG8_STAGE(PG8_SA(0, 1), a2 + hstep, voffA);
            PG8_WAIT_V(8); PG8_WAIT_L(0); PG8_BAR; PG8_MMA(0, 0, At, B0); PG8_MMA(0, 1, At, B1); PG8_BAR; PG8_SCHED;
            PG8_LDA(At, 1, 1); PG8_STAGE(PG8_SB(1, 0), b3, voffB); PG8_STAGE(PG8_SB(1, 1), b3 + hstep, voffB); PG8_STAGE(PG8_SA(1, 0), a3, voffA);
            PG8_WAIT_V(8); PG8_WAIT_L(0); PG8_BAR; PG8_MMA(1, 0, At, B0); PG8_MMA(1, 1, At, B1); PG8_BAR; PG8_SCHED;
            } else {
            PG8_LDB(B0, 0, 0); PG8_SCHED; PG8_LDA(At, 0, 0); PG8_STAGE(PG8_SA(1, 1), a1 + hstep, voffA);
            PG8_WAIT_L(8); PG8_BAR; PG8_WAIT_L(0); PG8_MMA(0, 0, At, B0); PG8_BAR; PG8_SCHED;
            PG8_LDB(B1, 0, 1); PG8_STAGE(PG8_SB(0, 0), b2, voffB);
            PG8_BAR; PG8_WAIT_L(0); PG8_MMA(0, 1, At, B1); PG8_BAR;
            PG8_LDA(At, 0, 1); PG8_STAGE(PG8_SA(0, 0), a2, voffA);
            PG8_BAR; PG8_WAIT_L(0); PG8_MMA(1, 0, At, B0); PG8_BAR; PG8_SCHED;
            PG8_STAGE(PG8_SB(0, 1), b2 + hstep, voffB);
            PG8_WAIT_V(6); PG8_BAR; PG8_MMA(1, 1, At, B1); PG8_BAR;
            PG8_LDB(B0, 1, 0); PG8_SCHED; PG8_LDA(At, 1, 0); PG8_STAGE(PG8_SA(0, 1), a2 + hstep, voffA);
            PG8_WAIT_L(8); PG8_BAR; PG8_WAIT_L(0); PG8_MMA(0, 0, At, B0); PG8_BAR; PG8_SCHED;
            PG8_LDB(B1, 1, 1); PG8_STAGE(PG8_SB(1, 0), b3, voffB);
            PG8_BAR; PG8_WAIT_L(0); PG8_MMA(0, 1, At, B1); PG8_BAR;
            PG8_LDA(At, 1, 1); PG8_STAGE(PG8_SA(1, 0), a3, voffA);
            PG8_BAR; PG8_WAIT_L(0); PG8_MMA(1, 0, At, B0); PG8_BAR; PG8_SCHED;
            PG8_STAGE(PG8_SB(1, 1), b3 + hstep, voffB);
            PG8_WAIT_V(6); PG8_BAR; PG8_MMA(1, 1, At, B1); PG8_BAR;
            }
        }
        if constexpr (ALIGN_EPI) { if (wr == 0) PG8_BAR; }
        if constexpr (!Epi::AFTER_DRAIN) {
            int l2_; asm volatile("v_mbcnt_lo_u32_b32 %0, -1, 0\n\tv_mbcnt_hi_u32_b32 %0, -1, %0" : "=v"(l2_));
            E(acc, cur, wr, wc, l2_ & 15, l2_ >> 4); S.done(cur); }
        if (!has_next) break;
        cur = nxt; cA = nA; cB = nB; ++ui;
        if constexpr (ALIGN_EPI) { if (wr == 1) PG8_BAR; }
    }
    PG8_WAIT_V(0);
    if constexpr (!ALIGN_EPI) { if (wr == 0) PG8_BAR; }
    PG8_BAR;
    if constexpr (Epi::AFTER_DRAIN) { E.fused(acc, cur, wr, wc, fr, fq, lds, wid, lane); S.done(cur); }
#undef PG8_SA
#undef PG8_SB
#undef PG8_STAGE
#undef PG8_LDA
#undef PG8_LDB
#undef PG8_MMA
#undef PG8_WAIT_V
#undef PG8_WAIT_L
#undef PG8_BAR
#undef PG8_SCHED
}
}


#define DI __device__ __forceinline__
using pg8::tid_hw; using pg8::hwslot_; using pg8::LDS_WID_TAB; using pg8::lds_raw;
DI int tid_fresh() { return tid_hw(); }
typedef unsigned short bf16_t;
typedef short bf16x8 __attribute__((ext_vector_type(8)));
typedef float f32x4 __attribute__((ext_vector_type(4)));
typedef unsigned u32x4 __attribute__((ext_vector_type(4)));
typedef unsigned u32x2 __attribute__((ext_vector_type(2)));
#define LAS __attribute__((address_space(3)))

constexpr int D = 1024, NB = 16, T = 2048, LC = 256;
constexpr int MLAT = NB * T, MCTX = NB * LC, MALL = MLAT + MCTX;
constexpr int NF = 4352;
constexpr int FFH = 2816;
constexpr float EPS = 1e-6f;
constexpr int F_AQ = 0, F_AZF = 512, F_AZB = 1024, F_AI = 1536, F_AOG = 2048, F_BQ = 2560, F_BK = 2816, F_BV = 3072, F_BR = 3584, F_LR = 4096;
constexpr int NTHREADS = 512, NWAVES = 8;
constexpr int LDS_BYTES = 147456;

constexpr size_t MiB = 1u << 20;
constexpr size_t WS_BAR = 0, WS_BAR_BYTES = 65536;
constexpr size_t WS_MODS = 1 * MiB;
constexpr size_t WS_ROPE = 2 * MiB;
constexpr size_t WS_LB = 3 * MiB;
constexpr size_t WS_WRI = 4 * MiB;
constexpr size_t WS_WRO = 13 * MiB;
constexpr size_t WS_WQKV = 15 * MiB;
constexpr size_t WS_WO = 18 * MiB;
constexpr size_t WS_WFI0 = 20 * MiB, WS_WFI1 = 31 * MiB;
constexpr size_t WS_WFO0 = 42 * MiB, WS_WFO1 = 48 * MiB;
constexpr size_t WS_XCTX = 56 * MiB;
constexpr size_t WS_U = 72 * MiB;
constexpr size_t WS_F = 144 * MiB;
constexpr size_t WS_Y = 144 * MiB;
constexpr size_t WS_H = 216 * MiB;
constexpr size_t WS_Q = 216 * MiB, WS_K = 280 * MiB, WS_V = 296 * MiB, WS_KC = 312 * MiB, WS_VC = 314 * MiB, WS_O = 316 * MiB;
constexpr size_t WS_XB = 414 * MiB;
constexpr size_t WS_END = 512 * MiB;

DI unsigned f2bf(float f) { unsigned u = __float_as_uint(f); return (u + 0x7fffu + ((u >> 16) & 1u)) >> 16; }
DI float bf2f(unsigned h) { return __uint_as_float(h << 16); }
DI unsigned pk2(float lo, float hi) { return f2bf(lo) | (f2bf(hi) << 16); }
DI float wave_sum(float v) {
#pragma unroll
    for (int o = 1; o < 64; o <<= 1) v += __shfl_xor(v, o);
    return v;
}
DI float sigmoid_f(float x) { return 1.f / (1.f + expf(-x)); }
DI float silu_f(float x) { return x / (1.f + expf(-x)); }
DI float logsigmoid_f(float z) { return fminf(z, 0.f) - log1pf(expf(-fabsf(z))); }

struct Args {
    const float *x, *c, *ctx, *c_ctx, *ada_w, *ada_b, *norm_g, *rec_w_in, *rec_w_out, *rec_lb, *rec_w_g2, *rec_b_g2, *gn_a, *gn_b, *att_w_qkv, *att_w_o, *att_sink, *ffn_w_in, *ffn_w_out;
    float* out; unsigned char* ws;
};

DI void transpose_item(const float* W, int ldw, int src_col0, bf16_t* WT, int K, int dst_row0, int k0, LAS float* scr, int lane, float scale = 1.f) {
#pragma unroll 16
    for (int kk = 0; kk < 64; ++kk) scr[kk * 65 + lane] = W[(size_t)(k0 + kk) * ldw + src_col0 + lane];
    asm volatile("s_waitcnt lgkmcnt(0)" ::: "memory");
    const int c = lane & 7;
#pragma unroll
    for (int j = 0; j < 8; ++j) { const int n = (lane >> 3) + 8 * j; const LAS float* s = scr + (8 * c) * 65 + n;
        u32x4 o; o.x = pk2(s[0 * 65] * scale, s[1 * 65] * scale); o.y = pk2(s[2 * 65] * scale, s[3 * 65] * scale); o.z = pk2(s[4 * 65] * scale, s[5 * 65] * scale); o.w = pk2(s[6 * 65] * scale, s[7 * 65] * scale);
        *(u32x4*)(WT + (size_t)(dst_row0 + n) * K + k0 + 8 * c) = o; }
    asm volatile("s_waitcnt lgkmcnt(0)" ::: "memory");
}
DI void phase_convert(const Args& a, LAS unsigned char* lds, int vcu, int G) {
    const int tidc = tid_fresh(); const int lane = tidc & 63, wid = tidc >> 6;
    LAS float* scr = (LAS float*)(lds + wid * 16640);
    const int gw = vcu * NWAVES + wid, NGW = G * NWAVES;
    constexpr int KB1 = D / 64, KB2 = FFH / 64;
    constexpr int I_RI = (4096 / 64) * KB1, I_RO = (D / 64) * KB1, I_QKV = (1536 / 64) * KB1, I_WO = (D / 64) * KB1, I_FI = (5632 / 64) * KB1, I_FO = (D / 64) * KB2;
    constexpr int NIT = I_RI + I_RO + I_QKV + I_WO + 2 * I_FI + 2 * I_FO;
    for (int it = gw; it < NIT; it += NGW) {
        int r = it;
        if (r < I_RI) { const int nb = r / KB1, kb = r % KB1; const int n0 = nb * 64;
            const int src = n0 < F_BR ? n0 : 3616 + (n0 - F_BR);
            transpose_item(a.rec_w_in, 4128, src, (bf16_t*)(a.ws + WS_WRI), D, n0, kb * 64, scr, lane); continue; }
        r -= I_RI;
        if (r < I_RO) { const int nb = r / KB1, kb = r % KB1; transpose_item(a.rec_w_out, D, nb * 64, (bf16_t*)(a.ws + WS_WRO), D, nb * 64, kb * 64, scr, lane); continue; }
        r -= I_RO;
        if (r < I_QKV) { const int nb = r / KB1, kb = r % KB1; transpose_item(a.att_w_qkv, 1536, nb * 64, (bf16_t*)(a.ws + WS_WQKV), D, nb * 64, kb * 64, scr, lane); continue; }
        r -= I_QKV;
        if (r < I_WO) { const int nb = r / KB1, kb = r % KB1; transpose_item(a.att_w_o, D, nb * 64, (bf16_t*)(a.ws + WS_WO), D, nb * 64, kb * 64, scr, lane); continue; }
        r -= I_WO;
        if (r < 2 * I_FI) { const int l = r / I_FI; r %= I_FI; const int nb = r / KB1, kb = r % KB1;
            const int p = nb >> 2, wq = nb & 3; const int src = wq < 2 ? p * 128 + 64 * wq : FFH + p * 128 + 64 * (wq - 2);
            transpose_item(a.ffn_w_in + (size_t)l * D * 5632, 5632, src, (bf16_t*)(a.ws + (l ? WS_WFI1 : WS_WFI0)), D, nb * 64, kb * 64, scr, lane, wq < 2 ? 1.4426950408889634f : 0.6931471805599453f); continue; }
        r -= 2 * I_FI;
        { const int l = r / I_FO; r %= I_FO; const int nb = r / KB2, kb = r % KB2;
            transpose_item(a.ffn_w_out + (size_t)l * FFH * D, D, nb * 64, (bf16_t*)(a.ws + (l ? WS_WFO1 : WS_WFO0)), FFH, nb * 64, kb * 64, scr, lane); }
    }
    const int gt = vcu * NTHREADS + tidc, NGT = G * NTHREADS;
    for (int it = gt; it < 256 * (D / 8); it += NGT) {
        const int k8 = it % (D / 8), n = it / (D / 8);
        u32x4 w4 = (u32x4){0u, 0u, 0u, 0u};
        if (n < 32) { float o[8];
#pragma unroll
            for (int kk = 0; kk < 8; ++kk) o[kk] = a.rec_w_in[(size_t)(k8 * 8 + kk) * 4128 + 3584 + n];
            w4.x = pk2(o[0], o[1]); w4.y = pk2(o[2], o[3]); w4.z = pk2(o[4], o[5]); w4.w = pk2(o[6], o[7]); }
        *(u32x4*)((bf16_t*)(a.ws + WS_WRI) + (size_t)(F_LR + n) * D + k8 * 8) = w4;
    }
    for (int it = gt; it < T * 32; it += NGT) { const int t = it >> 5, i = it & 31; const int row = t >> 6, col = t & 63;
        const float inv = powf(10000.f, -(float)(2 * (i & 15)) / 32.f); const float ang = (i < 16 ? (float)row : (float)col) * inv;
        float s, c; sincosf(ang, &s, &c); ((float*)(a.ws + WS_ROPE))[it] = c; ((float*)(a.ws + WS_ROPE))[T * 32 + it] = s; }
    for (int it = gt; it < 1024; it += NGT) { const float l0 = a.rec_lb[it], l1 = a.rec_lb[1024 + it]; ((float*)(a.ws + WS_LB))[it] = 1.f / (1.f + expf(l1 - l0)); }
}

DI void phase_adaln(const Args& a, LAS unsigned char* lds, int vcu, int G) {
    LAS float* sc = (LAS float*)lds;
    LAS float* red = (LAS float*)(lds + 17 * 1024 * 4);
    float* mods = (float*)(a.ws + WS_MODS);
    const int tida = tid_fresh(); const int lane = tida & 63, wid = tida >> 6, cx = tida & 15, kg = tida >> 4;
    for (int e = tida; e < 17 * 1024; e += NTHREADS) { const int s = e >> 10, k = e & 1023; const float cv = s < 16 ? a.c[s * D + k] : a.c_ctx[k]; sc[k * 17 + s] = silu_f(cv); }
    __syncthreads();
    for (int item = vcu; item < 256; item += G) {
        const int col0 = item * 48, l = col0 / 6144, j0 = col0 % 6144;
        float acc[3][17];
#pragma unroll
        for (int q = 0; q < 3; ++q)
#pragma unroll
            for (int s = 0; s < 17; ++s) acc[q][s] = 0.f;
        const float* w = a.ada_w + (size_t)l * D * 6144 + j0 + cx;
#pragma unroll 4
        for (int kk = 0; kk < 32; ++kk) { const int k = kg * 32 + kk; const float* wr = w + (size_t)k * 6144;
            const float w0 = wr[0], w1 = wr[16], w2 = wr[32];
#pragma unroll
            for (int s = 0; s < 17; ++s) { const float cv = sc[k * 17 + s]; acc[0][s] += cv * w0; acc[1][s] += cv * w1; acc[2][s] += cv * w2; } }
#pragma unroll
        for (int q = 0; q < 3; ++q)
#pragma unroll
            for (int s = 0; s < 17; ++s) { float v = acc[q][s]; v += __shfl_xor(v, 16); v += __shfl_xor(v, 32); if (lane < 16) red[(wid * 51 + q * 17 + s) * 16 + cx] = v; }
        __syncthreads();
        for (int e = tida; e < 51 * 16; e += NTHREADS) { const int qs = e >> 4, x = e & 15, q = qs / 17, s = qs % 17; float v = 0.f;
#pragma unroll
            for (int g = 0; g < 8; ++g) v += red[(g * 51 + qs) * 16 + x];
            const int j = j0 + q * 16 + x; mods[((size_t)l * 17 + s) * 6144 + j] = v + a.ada_b[l * 6144 + j]; }
        __syncthreads();
    }
}

struct RowArgs {
    const float* xold_lat; const float* xold_ctx;
    float* xnew_lat; float* xnew_ctx;
    const bf16_t* xold_b; bf16_t* xnew_b;
    const bf16_t* y;
    const bf16_t* yslab;
    bf16_t* u;
    const float* gY; const float* gU;
    const float* mods;
    const float* modsU;
    int gidx, sidx, nrows, pad;
};
typedef float f32x2r_t __attribute__((ext_vector_type(2))); typedef __bf16 bf16x2r_t __attribute__((ext_vector_type(2)));
DI unsigned cvtpk_r(float lo, float hi) { f32x2r_t v = {lo, hi}; bf16x2r_t b = __builtin_convertvector(v, bf16x2r_t); return __builtin_bit_cast(unsigned, b); }
DI void ld8f(const float* p, float (&o)[8]) { const f32x4 a = *(const f32x4*)p, b = *(const f32x4*)(p + 4); o[0] = a[0]; o[1] = a[1]; o[2] = a[2]; o[3] = a[3]; o[4] = b[0]; o[5] = b[1]; o[6] = b[2]; o[7] = b[3]; }
DI void ld8b(const bf16_t* p, float (&o)[8]) { const u32x4 w = *(const u32x4*)p;
#pragma unroll
    for (int i = 0; i < 4; ++i) { o[2 * i] = bf2f(w[i] & 0xffffu); o[2 * i + 1] = bf2f(w[i] >> 16); } }
DI u32x4 pk8(const float (&v)[8]) { return (u32x4){cvtpk_r(v[0], v[1]), cvtpk_r(v[2], v[3]), cvtpk_r(v[4], v[5]), cvtpk_r(v[6], v[7])}; }
template <int R>
DI void row_pass(const RowArgs& a, int row0, int rstride, int lane) {
    float x[R][2][8], y[R][2][8]; int rows[R]; bool ok[R];
#pragma unroll
    for (int i = 0; i < R; ++i) { rows[i] = row0 + i * rstride; ok[i] = rows[i] < a.nrows; if (!ok[i]) rows[i] = row0; }
#pragma unroll
    for (int i = 0; i < R; ++i) { const int row = rows[i]; const bool lat = row < MLAT;
#pragma unroll
        for (int j = 0; j < 2; ++j) { const int c = (64 * j + lane) * 8;
            if (a.xold_b) ld8b(a.xold_b + (size_t)row * D + c, x[i][j]);
            else ld8f((lat ? a.xold_lat + (size_t)row * D : a.xold_ctx + (size_t)(row - MLAT) * D) + c, x[i][j]);
            if (a.y) {
                if (a.yslab && !lat) { const bf16_t* ys = a.yslab + (size_t)(row - MLAT) * D + c; float t1[8], t2[8], t3[8];
                    ld8b(ys, y[i][j]); ld8b(ys + (size_t)MCTX * D, t1); ld8b(ys + (size_t)2 * MCTX * D, t2); ld8b(ys + (size_t)3 * MCTX * D, t3);
#pragma unroll
                    for (int e = 0; e < 8; ++e) y[i][j][e] = (y[i][j][e] + t1[e]) + (t2[e] + t3[e]); }
                else ld8b(a.y + (size_t)row * D + c, y[i][j]); } } }
    const int s0 = rows[0] < MLAT ? rows[0] / T : 16;
    float gy[2][8], gt[2][8], gu[2][8], sh[2][8], sc[2][8];
#pragma unroll
    for (int j = 0; j < 2; ++j) { const int c = (64 * j + lane) * 8;
        if (a.y) { ld8f(a.gY + c, gy[j]); ld8f(a.mods + (size_t)s0 * 6144 + a.gidx * D + c, gt[j]); }
        if (a.u) { ld8f(a.gU + c, gu[j]); ld8f(a.modsU + (size_t)s0 * 6144 + a.sidx * D + c, sh[j]); ld8f(a.modsU + (size_t)s0 * 6144 + (a.sidx + 1) * D + c, sc[j]); } }
    if (a.y) {
        float ss[R];
#pragma unroll
        for (int i = 0; i < R; ++i) { ss[i] = 0.f;
#pragma unroll
            for (int j = 0; j < 2; ++j)
#pragma unroll
                for (int e = 0; e < 8; ++e) ss[i] += y[i][j][e] * y[i][j][e]; }
#pragma unroll
        for (int o = 1; o < 64; o <<= 1)
#pragma unroll
            for (int i = 0; i < R; ++i) ss[i] += __shfl_xor(ss[i], o);
#pragma unroll
        for (int i = 0; i < R; ++i) { const int row = rows[i]; const bool lat = row < MLAT;
            const float r = rsqrtf(ss[i] * (1.f / D) + EPS);
#pragma unroll
            for (int j = 0; j < 2; ++j) { const int c = (64 * j + lane) * 8;
#pragma unroll
                for (int e = 0; e < 8; ++e) x[i][j][e] += gt[j][e] * (y[i][j][e] * r * gy[j][e]);
                if (ok[i]) {
                    if (lat ? a.xnew_lat != nullptr : a.xnew_ctx != nullptr) { float* xn = (lat ? a.xnew_lat + (size_t)row * D : a.xnew_ctx + (size_t)(row - MLAT) * D) + c;
                        *(f32x4*)xn = (f32x4){x[i][j][0], x[i][j][1], x[i][j][2], x[i][j][3]}; *(f32x4*)(xn + 4) = (f32x4){x[i][j][4], x[i][j][5], x[i][j][6], x[i][j][7]}; }
                    if (a.xnew_b) { const u32x4 w = pk8(x[i][j]); *(u32x4*)(a.xnew_b + (size_t)row * D + c) = w;
#pragma unroll
                        for (int e = 0; e < 4; ++e) { x[i][j][2 * e] = bf2f(w[e] & 0xffffu); x[i][j][2 * e + 1] = bf2f(w[e] >> 16); } } } }
        }
    }
    if (a.u) {
        float ss[R];
#pragma unroll
        for (int i = 0; i < R; ++i) { ss[i] = 0.f;
#pragma unroll
            for (int j = 0; j < 2; ++j)
#pragma unroll
                for (int e = 0; e < 8; ++e) ss[i] += x[i][j][e] * x[i][j][e]; }
#pragma unroll
        for (int o = 1; o < 64; o <<= 1)
#pragma unroll
            for (int i = 0; i < R; ++i) ss[i] += __shfl_xor(ss[i], o);
#pragma unroll
        for (int i = 0; i < R; ++i) { const int row = rows[i];
            const float r = rsqrtf(ss[i] * (1.f / D) + EPS);
            if (ok[i]) {
#pragma unroll
                for (int j = 0; j < 2; ++j) { const int c = (64 * j + lane) * 8; float o[8];
#pragma unroll
                    for (int e = 0; e < 8; ++e) o[e] = (x[i][j][e] * r * gu[j][e]) * (sc[j][e] + 1.f) + sh[j][e];
                    *(u32x4*)(a.u + (size_t)row * D + c) = pk8(o); } } }
    }
}
DI void phase_rows(const RowArgs& a, int vcu, int G) {
    constexpr int R = 2;
    const int tidr = tid_fresh(); const int lane = tidr & 63; const int gw = vcu * NWAVES + (tidr >> 6), NGW = G * NWAVES;
    for (int row = R * gw; row < a.nrows; row += R * NGW) row_pass<R>(a, row, 1, lane);
}

typedef float f32x16 __attribute__((ext_vector_type(16)));
typedef short s16x4 __attribute__((ext_vector_type(4)));
typedef float f32x2_t __attribute__((ext_vector_type(2))); typedef __bf16 bf16x2_t __attribute__((ext_vector_type(2)));
DI unsigned cvtpk(float lo, float hi) { f32x2_t v = {lo, hi}; bf16x2_t b = __builtin_convertvector(v, bf16x2_t); return __builtin_bit_cast(unsigned, b); }
DI s16x4 tr16(const LAS unsigned char* p) { return __builtin_bit_cast(s16x4, __builtin_amdgcn_ds_read_tr16_b64_v4i16((LAS s16x4*)p)); }
DI int crow(int i, int hi) { return (i & 3) + 8 * (i >> 2) + 4 * hi; }
constexpr float LOG2E = 1.4426950408889634f;
DI int swap23(int q) { return (q & 3) | ((q & 4) << 1) | ((q & 8) >> 1); }
DI int scan_rbase(int b, int dir, int n) { return n < 8 ? MLAT + b * LC + (dir ? LC - 1 - 32 * n : 32 * n) : b * T + (dir ? T - 1 - 32 * (n - 8) : 32 * (n - 8)); }
DI bf16x8 pack8(const f32x16& x, int s) { u32x4 p; p.x = cvtpk(x[8 * s], x[8 * s + 1]); p.y = cvtpk(x[8 * s + 2], x[8 * s + 3]); p.z = cvtpk(x[8 * s + 4], x[8 * s + 5]); p.w = cvtpk(x[8 * s + 6], x[8 * s + 7]); return __builtin_bit_cast(bf16x8, p); }
struct ScanRaw { u32x4 q[2], z[2], v[2]; };
DI float dpp_shr_f(float old, float v, int n) {
    const int o = __builtin_bit_cast(int, old), x = __builtin_bit_cast(int, v); int r;
    switch (n) { case 1: r = __builtin_amdgcn_update_dpp(o, x, 0x111, 0xf, 0xf, false); break; case 2: r = __builtin_amdgcn_update_dpp(o, x, 0x112, 0xf, 0xf, false); break;
                 case 4: r = __builtin_amdgcn_update_dpp(o, x, 0x114, 0xf, 0xf, false); break; default: r = __builtin_amdgcn_update_dpp(o, x, 0x118, 0xf, 0xf, false); break; }
    return __builtin_bit_cast(float, r); }
DI void unpack8(const u32x4& w, float (&o)[8]) {
#pragma unroll
    for (int i = 0; i < 4; ++i) { o[2 * i] = bf2f(w[i] & 0xffffu); o[2 * i + 1] = bf2f(w[i] >> 16); } }
template <int KD>
DI void scan_load(ScanRaw& R, const bf16_t* __restrict__ F, int b, int hh, int dir, int n, int ptid, int lane, int pw) {
    const int rb = scan_rbase(b, dir, n), st = dir ? -1 : 1;
    if (KD == 128) { const int tp = lane & 15, cg = pw * 4 + (lane >> 4);
#pragma unroll
        for (int e = 0; e < 2; ++e) { const bf16_t* f = F + (size_t)(rb + st * (2 * tp + e)) * NF + hh * 128 + cg * 8;
            R.q[e] = *(const u32x4*)(f + F_AQ); R.z[e] = *(const u32x4*)(f + (dir ? F_AZB : F_AZF)); } }
    else { const int cg = ptid >> 5, tok = ptid & 31; const bf16_t* f = F + (size_t)(rb + st * tok) * NF + hh * 64 + cg * 8;
        R.q[0] = *(const u32x4*)(f + F_BQ); R.q[1] = *(const u32x4*)(f + F_BK); }
#pragma unroll
    for (int i = 0; i < 2; ++i) { const int e = ptid + 256 * i, p = e >> 4, vc8 = e & 15;
        R.v[i] = *(const u32x4*)(F + (size_t)(rb + st * p) * NF + (KD == 128 ? F_AI : F_BV) + hh * 128 + 8 * vc8); }
}
template <int KD>
DI void scan_process(const ScanRaw& R, LAS unsigned char* buf, int ptid, int lane, int pw, const LAS float* gx, const float (&cst)[8]) {
    constexpr int QSTR = KD * 2 + 16, QDB = 32 * QSTR, OFF_KE = QDB, OFF_V = 2 * QDB, OFF_DK = OFF_V + 8192;
    if (KD == 128) {
        const int tp = lane & 15, cg = pw * 4 + (lane >> 4);
        float k0[8], k1[8], q0[8], q1[8], inc[8];
        unpack8(R.z[0], k0); unpack8(R.z[1], k1); unpack8(R.q[0], q0); unpack8(R.q[1], q1);
#pragma unroll
        for (int i = 0; i < 8; ++i) inc[i] = (1.f - k0[i]) * (1.f - k1[i]);
#pragma unroll
        for (int d = 1; d < 16; d <<= 1)
#pragma unroll
            for (int i = 0; i < 8; ++i) inc[i] *= dpp_shr_f(1.f, inc[i], d);
        float o0[8], o1[8], e0[8], e1[8], pl[8];
#pragma unroll
        for (int i = 0; i < 8; ++i) { const float ex = dpp_shr_f(1.f, inc[i], 1); pl[i] = __shfl(inc[i], lane | 15);
            const float c0 = ex * (1.f - k0[i]), c1 = inc[i]; const float rp = __builtin_amdgcn_rcpf(pl[i]);
            o0[i] = q0[i] * (c0 * rp); o1[i] = q1[i] * (c1 * rp); e0[i] = k0[i] * (pl[i] * __builtin_amdgcn_rcpf(c0)); e1[i] = k1[i] * (pl[i] * __builtin_amdgcn_rcpf(c1)); }
        LAS unsigned char* p0 = buf + (2 * tp) * QSTR + cg * 16;
        *(LAS u32x4*)p0 = (u32x4){cvtpk(o0[0], o0[1]), cvtpk(o0[2], o0[3]), cvtpk(o0[4], o0[5]), cvtpk(o0[6], o0[7])};
        *(LAS u32x4*)(p0 + QSTR) = (u32x4){cvtpk(o1[0], o1[1]), cvtpk(o1[2], o1[3]), cvtpk(o1[4], o1[5]), cvtpk(o1[6], o1[7])};
        *(LAS u32x4*)(p0 + OFF_KE) = (u32x4){cvtpk(e0[0], e0[1]), cvtpk(e0[2], e0[3]), cvtpk(e0[4], e0[5]), cvtpk(e0[6], e0[7])};
        *(LAS u32x4*)(p0 + OFF_KE + QSTR) = (u32x4){cvtpk(e1[0], e1[1]), cvtpk(e1[2], e1[3]), cvtpk(e1[4], e1[5]), cvtpk(e1[6], e1[7])};
        if (tp == 0) { *(LAS f32x4*)(buf + OFF_DK + cg * 32) = (f32x4){pl[0], pl[1], pl[2], pl[3]}; *(LAS f32x4*)(buf + OFF_DK + cg * 32 + 16) = (f32x4){pl[4], pl[5], pl[6], pl[7]}; }
    } else {
        const int cg = ptid >> 5, tok = ptid & 31;
        float bc[8], q[8], k[8], bl[8];
        unpack8(R.q[0], q); unpack8(R.q[1], k);
#pragma unroll
        for (int i = 0; i < 8; ++i) { const float x = gx[(cg * 8 + i) * 32 + tok] + cst[i]; const float e = __builtin_amdgcn_exp2f(-LOG2E * fabsf(x));
            bc[i] = (fminf(x, 0.f) * LOG2E - __builtin_amdgcn_logf(1.f + e)) * (1.f / 16.f); }
#pragma unroll
        for (int d = 1; d < 16; d <<= 1)
#pragma unroll
            for (int i = 0; i < 8; ++i) bc[i] += dpp_shr_f(0.f, bc[i], d);
#pragma unroll
        for (int i = 0; i < 8; ++i) { const float t0 = __shfl(bc[i], (lane & 32) + 15); if (lane & 16) bc[i] += t0; bl[i] = __shfl(bc[i], lane | 31); }
        float o[8], e[8];
#pragma unroll
        for (int i = 0; i < 8; ++i) { const float w = __builtin_amdgcn_exp2f(bl[i] - bc[i]); e[i] = k[i] * w; o[i] = q[i] * 0.125f * __builtin_amdgcn_rcpf(w); }
        LAS unsigned char* p0 = buf + tok * QSTR + cg * 16;
        *(LAS u32x4*)p0 = (u32x4){cvtpk(o[0], o[1]), cvtpk(o[2], o[3]), cvtpk(o[4], o[5]), cvtpk(o[6], o[7])};
        *(LAS u32x4*)(p0 + OFF_KE) = (u32x4){cvtpk(e[0], e[1]), cvtpk(e[2], e[3]), cvtpk(e[4], e[5]), cvtpk(e[6], e[7])};
        if (tok == 0) { *(LAS f32x4*)(buf + OFF_DK + cg * 32) = (f32x4){__builtin_amdgcn_exp2f(bl[0]), __builtin_amdgcn_exp2f(bl[1]), __builtin_amdgcn_exp2f(bl[2]), __builtin_amdgcn_exp2f(bl[3])};
            *(LAS f32x4*)(buf + OFF_DK + cg * 32 + 16) = (f32x4){__builtin_amdgcn_exp2f(bl[4]), __builtin_amdgcn_exp2f(bl[5]), __builtin_amdgcn_exp2f(bl[6]), __builtin_amdgcn_exp2f(bl[7])}; }
    }
#pragma unroll
    for (int i = 0; i < 2; ++i) { const int e = ptid + 256 * i, p = e >> 4, vc8 = e & 15; *(LAS u32x4*)(buf + OFF_V + (vc8 >> 2) * 2048 + p * 64 + (vc8 & 3) * 16) = R.v[i]; }
}

#define SCAN_BAR() asm volatile("s_waitcnt lgkmcnt(0)\n\ts_barrier" ::: "memory")
DI void scan_store_o(const LAS unsigned char* ob, bf16_t* O, int b, int dir, int n, int ocol0, int tid) {
    const int tok = tid >> 4, pc = tid & 15; const int rb = scan_rbase(b, dir, n), stp = dir ? -1 : 1;
    const u32x4 w = *(const LAS u32x4*)(ob + tok * 272 + pc * 16);
    *(u32x4*)(O + (size_t)(rb + stp * tok) * D + ocol0 + pc * 8) = w;
}
template <int KD>
DI void scan_mfma_task(int b, int hh, int dir, const bf16_t* __restrict__ F, bf16_t* O, const float* w_g2, const float* b_g2, LAS unsigned char* lds) {
    constexpr int NKT = KD / 32, QSTR = KD * 2 + 16, QDB = 32 * QSTR, OFF_KE = QDB, OFF_V = 2 * QDB, OFF_DK = OFF_V + 8192, BUF = OFF_DK + KD * 4, OSTR = 272, OB0 = 2 * BUF, OBB = 32 * OSTR;
    constexpr int NCH = (LC + T) / 32; static_assert(NCH % 6 == 0, "producer loop is unrolled by 6");
    constexpr int GX0 = 73728, GXB = 8192;
    const int tid = tid_fresh(), lane = tid & 63, wid = __builtin_amdgcn_readfirstlane(tid >> 6);
    const int ocol0 = (KD == 128 ? 0 : 512) + hh * 128;
    if (wid < 4) {
        const int vt = wid, r = lane & 31, hi = lane >> 5;
        f32x16 S[NKT];
#pragma unroll
        for (int kt = 0; kt < NKT; ++kt)
#pragma unroll
            for (int i = 0; i < 16; ++i) S[kt][i] = 0.f;
        const unsigned qrd = r * QSTR + hi * 16;
        const unsigned vrd = vt * 2048 + ((lane >> 4) & 1) * 32 + (lane & 3) * 8 + (4 * hi + ((lane & 15) >> 2)) * 64;
        const unsigned ktr = (4 * hi + ((lane & 15) >> 2)) * QSTR + (((lane >> 4) & 1) * 16 + 8 * (lane & 1) + 4 * ((lane >> 1) & 1)) * 2;
        bf16x8 gwB[2]; bf16x8 lrA;
        const int st_ = dir ? -1 : 1;
#define SCAN_LR_LOAD(c) (*(const bf16x8*)(F + (size_t)(scan_rbase(b, dir, (c)) + st_ * r) * NF + F_LR + dir * 16 + 8 * hi))
#define SCAN_GATES(c, LRV) do { f32x16 z_; _Pragma("unroll") for (int i_ = 0; i_ < 16; ++i_) z_[i_] = 0.f; \
            LAS unsigned char* gs_ = lds + GX0 + ((c) & 1) * GXB; \
            _Pragma("unroll") for (int tl_ = 0; tl_ < 2; ++tl_) { const f32x16 gx_ = __builtin_amdgcn_mfma_f32_32x32x16_bf16(LRV, gwB[tl_], z_, 0, 0, 0); \
                _Pragma("unroll") for (int g4_ = 0; g4_ < 4; ++g4_) *(LAS f32x4*)(gs_ + ((tl_ * 32 + r) * 32 + 8 * g4_ + 4 * hi) * 4) = (f32x4){gx_[4 * g4_], gx_[4 * g4_ + 1], gx_[4 * g4_ + 2], gx_[4 * g4_ + 3]}; } } while (0)
        if (KD == 64 && vt == 0) {
#pragma unroll
            for (int tl = 0; tl < 2; ++tl) { float wv[8];
#pragma unroll
                for (int j = 0; j < 8; ++j) wv[j] = w_g2[(size_t)(dir * 16 + 8 * hi + j) * 256 + hh * 64 + tl * 32 + r];
                const u32x4 wp = (u32x4){cvtpk(wv[0], wv[1]), cvtpk(wv[2], wv[3]), cvtpk(wv[4], wv[5]), cvtpk(wv[6], wv[7])}; gwB[tl] = __builtin_bit_cast(bf16x8, wp); }
            const bf16x8 l0 = SCAN_LR_LOAD(0), l1 = SCAN_LR_LOAD(1); lrA = SCAN_LR_LOAD(2);
            SCAN_GATES(0, l0); SCAN_GATES(1, l1);
        }
        SCAN_BAR();
        SCAN_BAR();
        for (int n = 0; n < NCH; ++n) {
            const LAS unsigned char* B0 = lds + (n & 1) * BUF;
            if (KD == 64 && vt == 0 && n + 2 < NCH) { const bf16x8 cur_ = lrA; if (n + 3 < NCH) lrA = SCAN_LR_LOAD(n + 3); SCAN_GATES(n + 2, cur_); }
            if (n > 0) scan_store_o(lds + OB0 + ((n - 1) & 1) * OBB, O, b, dir, n - 1, ocol0, tid);
            { f32x4 dk[NKT][4];
#pragma unroll
              for (int kt = 0; kt < NKT; ++kt)
#pragma unroll
                  for (int g4 = 0; g4 < 4; ++g4) dk[kt][g4] = *(const LAS f32x4*)(B0 + OFF_DK + (kt * 32 + 16 * (g4 >> 1) + 8 * hi + 4 * (g4 & 1)) * 4);
              __builtin_amdgcn_sched_barrier(0);
#pragma unroll
              for (int kt = 0; kt < NKT; ++kt)
#pragma unroll
                  for (int g4 = 0; g4 < 4; ++g4) { S[kt][4 * g4] *= dk[kt][g4][0]; S[kt][4 * g4 + 1] *= dk[kt][g4][1]; S[kt][4 * g4 + 2] *= dk[kt][g4][2]; S[kt][4 * g4 + 3] *= dk[kt][g4][3]; } }
            f32x16 o, sc;
#pragma unroll
            for (int i = 0; i < 16; ++i) { o[i] = 0.f; sc[i] = 0.f; }
            { bf16x8 qd[2 * NKT], ke[2 * NKT];
#pragma unroll
              for (int ks = 0; ks < 2 * NKT; ++ks) { qd[ks] = *(const LAS bf16x8*)(B0 + qrd + ks * 32); ke[ks] = *(const LAS bf16x8*)(B0 + OFF_KE + qrd + ks * 32); }
              __builtin_amdgcn_sched_barrier(0);
#pragma unroll
              for (int kt = 0; kt < NKT; ++kt)
#pragma unroll
                  for (int s2 = 0; s2 < 2; ++s2) { o = __builtin_amdgcn_mfma_f32_32x32x16_bf16(qd[2 * kt + s2], pack8(S[kt], s2), o, 0, 0, 0);
                      sc = __builtin_amdgcn_mfma_f32_32x32x16_bf16(ke[2 * kt + s2], qd[2 * kt + s2], sc, 0, 0, 0); } }
            { s16x4 vlo[2], vhi[2], klo[NKT][2], khi[NKT][2];
#pragma unroll
              for (int s2 = 0; s2 < 2; ++s2) { vlo[s2] = tr16(B0 + OFF_V + vrd + s2 * 1024); vhi[s2] = tr16(B0 + OFF_V + vrd + s2 * 1024 + 512); }
#pragma unroll
              for (int kt = 0; kt < NKT; ++kt)
#pragma unroll
                  for (int s2 = 0; s2 < 2; ++s2) { const LAS unsigned char* kp = B0 + OFF_KE + ktr + kt * 64 + s2 * (16 * QSTR); klo[kt][s2] = tr16(kp); khi[kt][s2] = tr16(kp + 8 * QSTR); }
              __builtin_amdgcn_sched_barrier(0);
#pragma unroll
              for (int i = 0; i < 16; ++i) if (crow(i, hi) > r) sc[i] = 0.f;
              bf16x8 vb[2];
#pragma unroll
              for (int s2 = 0; s2 < 2; ++s2) vb[s2] = (bf16x8){vlo[s2][0], vlo[s2][1], vlo[s2][2], vlo[s2][3], vhi[s2][0], vhi[s2][1], vhi[s2][2], vhi[s2][3]};
#pragma unroll
              for (int s2 = 0; s2 < 2; ++s2) o = __builtin_amdgcn_mfma_f32_32x32x16_bf16(pack8(sc, s2), vb[s2], o, 0, 0, 0);
#pragma unroll
              for (int kt = 0; kt < NKT; ++kt)
#pragma unroll
                  for (int s2 = 0; s2 < 2; ++s2) { const bf16x8 ket = (bf16x8){klo[kt][s2][0], klo[kt][s2][1], klo[kt][s2][2], klo[kt][s2][3], khi[kt][s2][0], khi[kt][s2][1], khi[kt][s2][2], khi[kt][s2][3]};
                      S[kt] = __builtin_amdgcn_mfma_f32_32x32x16_bf16(ket, vb[s2], S[kt], 0, 0, 0); } }
            { LAS unsigned char* ob = lds + OB0 + (n & 1) * OBB + (vt * 32 + r) * 2;
#pragma unroll
              for (int i = 0; i < 16; ++i) *(LAS unsigned short*)(ob + crow(i, hi) * OSTR) = (unsigned short)cvtpk(o[i], o[i]); }
            SCAN_BAR();
        }
        scan_store_o(lds + OB0 + ((NCH - 1) & 1) * OBB, O, b, dir, NCH - 1, ocol0, tid);
#undef SCAN_LR_LOAD
#undef SCAN_GATES
    } else {
        const int ptid = tid - 256, pw = wid - 4;
        ScanRaw r0, r1, r2;
        scan_load<KD>(r0, F, b, hh, dir, 0, ptid, lane, pw);
        scan_load<KD>(r1, F, b, hh, dir, 1, ptid, lane, pw);
        scan_load<KD>(r2, F, b, hh, dir, 2, ptid, lane, pw);
        float cst[8];
#pragma unroll
        for (int i = 0; i < 8; ++i) cst[i] = KD == 64 ? b_g2[dir * 256 + hh * 64 + (ptid >> 5) * 8 + i] : 0.f;
        const LAS float* gx0 = (const LAS float*)(lds + GX0); const LAS float* gx1 = (const LAS float*)(lds + GX0 + GXB);
        SCAN_BAR();
        scan_process<KD>(r0, lds, ptid, lane, pw, gx0, cst);
        SCAN_BAR();
#define SCAN_IT(nn, LD, PR, BOFF) do { if ((nn) > 0) scan_store_o(lds + OB0 + (((nn) - 1) & 1) * OBB, O, b, dir, (nn) - 1, ocol0, tid); \
            if ((nn) + 3 < NCH) scan_load<KD>(LD, F, b, hh, dir, (nn) + 3, ptid, lane, pw); \
            if ((nn) + 1 < NCH) scan_process<KD>(PR, lds + (BOFF), ptid, lane, pw, (BOFF) ? gx1 : gx0, cst); SCAN_BAR(); } while (0)
        for (int n = 0; n < NCH; n += 6) {
            SCAN_IT(n,     r0, r1, BUF);
            SCAN_IT(n + 1, r1, r2, 0);
            SCAN_IT(n + 2, r2, r0, BUF);
            SCAN_IT(n + 3, r0, r1, 0);
            SCAN_IT(n + 4, r1, r2, BUF);
            SCAN_IT(n + 5, r2, r0, 0);
        }
#undef SCAN_IT
        scan_store_o(lds + OB0 + ((NCH - 1) & 1) * OBB, O, b, dir, NCH - 1, ocol0, tid);
    }
}

DI float silu_fastc(float x) { return x * __builtin_amdgcn_rcpf(1.f + __builtin_amdgcn_exp2f(-1.4426950408889634f * x)); }
DI void phase_combine(const bf16_t* Of, const bf16_t* Ob, const bf16_t* __restrict__ F, const float* gn_a, const float* gn_b, bf16_t* Yg, int vcu, int G) {
    const int tidm = tid_fresh(); const int lane = tidm & 63; const int gw = vcu * NWAVES + (tidm >> 6), NGW = G * NWAVES;
    const int c0 = 16 * lane; const int fc = c0 < 512 ? F_AOG + c0 : F_BR + (c0 - 512);
    float gnv[16];
#pragma unroll
    for (int i = 0; i < 16; ++i) gnv[i] = (c0 < 512 ? gn_a : gn_b)[(c0 & 127) + i];
    for (int row0 = 2 * gw; row0 < MALL; row0 += 2 * NGW) {
        u32x4 av[2][2], bv[2][2], gv[2][2];
#pragma unroll
        for (int i = 0; i < 2; ++i) { const size_t row = row0 + i;
            av[i][0] = *(const u32x4*)(Of + row * D + c0); av[i][1] = *(const u32x4*)(Of + row * D + c0 + 8);
            bv[i][0] = *(const u32x4*)(Ob + row * D + c0); bv[i][1] = *(const u32x4*)(Ob + row * D + c0 + 8);
            gv[i][0] = *(const u32x4*)(F + row * NF + fc); gv[i][1] = *(const u32x4*)(F + row * NF + fc + 8); }
#pragma unroll
        for (int i = 0; i < 2; ++i) { const size_t row = row0 + i; float o[16], gt[16]; float ss = 0.f;
#pragma unroll
            for (int h2 = 0; h2 < 2; ++h2)
#pragma unroll
                for (int e = 0; e < 4; ++e) { o[8 * h2 + 2 * e] = bf2f(av[i][h2][e] & 0xffffu) + bf2f(bv[i][h2][e] & 0xffffu); o[8 * h2 + 2 * e + 1] = bf2f(av[i][h2][e] >> 16) + bf2f(bv[i][h2][e] >> 16);
                    gt[8 * h2 + 2 * e] = bf2f(gv[i][h2][e] & 0xffffu); gt[8 * h2 + 2 * e + 1] = bf2f(gv[i][h2][e] >> 16); }
#pragma unroll
            for (int e = 0; e < 16; ++e) ss += o[e] * o[e];
            ss += __shfl_xor(ss, 1); ss += __shfl_xor(ss, 2); ss += __shfl_xor(ss, 4);
            const float r = rsqrtf(ss * (1.f / 128.f) + EPS);
            unsigned wv[8];
#pragma unroll
            for (int e = 0; e < 8; ++e) wv[e] = cvtpk_r(o[2 * e] * r * gnv[2 * e] * silu_fastc(gt[2 * e]), o[2 * e + 1] * r * gnv[2 * e + 1] * silu_fastc(gt[2 * e + 1]));
            *(u32x4*)(Yg + row * D + c0) = (u32x4){wv[0], wv[1], wv[2], wv[3]}; *(u32x4*)(Yg + row * D + c0 + 8) = (u32x4){wv[4], wv[5], wv[6], wv[7]}; }
    }
}

constexpr int AT_KB = 9216, AT_VB = 8192, AT_K0 = 0, AT_V0 = 2 * AT_KB, AT_Q0 = AT_V0 + 2 * AT_VB, AT_K2 = AT_Q0 + 8 * 9216, AT_V2 = AT_K2 + AT_KB;
static_assert(AT_V2 + AT_VB <= LDS_BYTES - 64, "attention LDS");
constexpr int AT_DUMMY_ = 0;

DI void attn_tile_src(int t, int b, int kv, int blk, bool hasp, bool hasn, const bf16_t* Kl, const bf16_t* Vl, const bf16_t* Kc, const bf16_t* Vc, const bf16_t*& kp, const bf16_t*& vp, int& type, int& te) {
    size_t row0; const bf16_t *kb_ = Kl, *vb_ = Vl;
    if (t < 2) { row0 = (size_t)b * T + blk * 128 + t * 64; type = 0; te = 0; }
    else if (t < 6) { row0 = (size_t)b * LC + (t - 2) * 64; kb_ = Kc; vb_ = Vc; type = 0; te = 0; }
    else { const int e = t - 6;
        if (hasp && e == 0) { row0 = (size_t)b * T + (blk - 1) * 128 + 64; type = 1; te = 1; }
        else if (hasn && e == (hasp ? 1 : 0)) { row0 = (size_t)b * T + (blk + 1) * 128; type = 2; te = 0; }
        else { row0 = (size_t)b * T + (hasp ? blk - 1 : blk) * 128; type = 1; te = 0; } }
    kp = kb_ + row0 * 256 + kv * 64; vp = vb_ + row0 * 256 + kv * 64;
}

DI void attn_phase(const bf16_t* __restrict__ Q, const bf16_t* __restrict__ Kl, const bf16_t* __restrict__ Vl, const bf16_t* __restrict__ Kc, const bf16_t* __restrict__ Vc,
                   const float* sink, bf16_t* O, LAS unsigned char* lds, int vcu, int G) {
    const int tid = tid_fresh(), lane = tid & 63, wid = __builtin_amdgcn_readfirstlane(tid >> 6), r = lane & 31, hi = lane >> 5;
    const int skey = tid >> 3, sc = tid & 7;
    const unsigned kwr = skey * 144 + sc * 16, vwr = (sc >> 2) * 4096 + skey * 64 + (sc & 3) * 16;
    const unsigned krd = r * 144 + hi * 16;
    const unsigned vrd = ((lane >> 4) & 1) * 32 + (lane & 3) * 8 + (4 * hi + ((lane & 15) >> 2)) * 64;
    const int g = wid >> 1, qhalf = wid & 1;
    LAS unsigned char* Qw = lds + AT_Q0 + wid * 9216;
    const float NEG = -1e30f;
    for (int unit = vcu; unit < NB * 4 * 16; unit += G) {
        const int blk = unit & 15, kv = (unit >> 4) & 3, b = unit >> 6, h = kv * 4 + g;
        const bool hasp = blk > 0, hasn = blk < 15; const int NT = 7 + (hasp ? 1 : 0) + (hasn ? 1 : 0);
        const size_t qrow0 = (size_t)b * T + blk * 128 + qhalf * 64;
        const bf16_t *kp, *vp; int type, te;
        attn_tile_src(0, b, kv, blk, hasp, hasn, Kl, Vl, Kc, Vc, kp, vp, type, te);
        u32x4 kreg2 = {0u, 0u, 0u, 0u}, vreg2 = {0u, 0u, 0u, 0u};
        u32x4 kreg = *(const u32x4*)(kp + (size_t)skey * 256 + sc * 8), vreg = *(const u32x4*)(vp + (size_t)skey * 256 + sc * 8);
        { u32x4 qv[8];
#pragma unroll
          for (int i = 0; i < 8; ++i) qv[i] = *(const u32x4*)(Q + (qrow0 + i * 8 + (lane >> 3)) * 1024 + h * 64 + (lane & 7) * 8);
#pragma unroll
          for (int i = 0; i < 8; ++i) *(LAS u32x4*)(Qw + (i * 8 + (lane >> 3)) * 144 + (lane & 7) * 16) = qv[i]; }
        *(LAS u32x4*)(lds + AT_K0 + kwr) = kreg; *(LAS u32x4*)(lds + AT_V0 + vwr) = vreg;
        int typen, ten;
        attn_tile_src(1, b, kv, blk, hasp, hasn, Kl, Vl, Kc, Vc, kp, vp, typen, ten);
        kreg = *(const u32x4*)(kp + (size_t)skey * 256 + sc * 8); vreg = *(const u32x4*)(vp + (size_t)skey * 256 + sc * 8);
        u32x4 kregn = kreg, vregn = vreg;
        f32x16 ot[2][2];
#pragma unroll
        for (int dh = 0; dh < 2; ++dh)
#pragma unroll
            for (int qt = 0; qt < 2; ++qt)
#pragma unroll
                for (int i = 0; i < 16; ++i) ot[dh][qt][i] = 0.f;
        float m[2] = {0.f, 0.f}, l[2] = {0.f, 0.f};
        __syncthreads();
        for (int t = 0; t < NT; ++t) {
            const int cur = t & 1; const int stype = type, ste = te; const bool fin = t == NT - 1, nfin = t + 1 == NT - 1, nnfin = t + 2 == NT - 1;
            int typenn = 0, tenn = 0;
            if (t + 2 < NT) { attn_tile_src(t + 2, b, kv, blk, hasp, hasn, Kl, Vl, Kc, Vc, kp, vp, typenn, tenn);
                if (!nnfin || hasp) { kregn = *(const u32x4*)(kp + (size_t)skey * 256 + sc * 8); vregn = *(const u32x4*)(vp + (size_t)skey * 256 + sc * 8); }
                if (nnfin && hasn) { const size_t o2 = ((size_t)b * T + (blk + 1) * 128 + 64 + skey) * 256 + kv * 64 + sc * 8; kreg2 = *(const u32x4*)(Kl + o2); vreg2 = *(const u32x4*)(Vl + o2); } }
            const LAS unsigned char* Kb = fin && qhalf ? lds + AT_K2 : lds + AT_K0 + cur * AT_KB; const LAS unsigned char* Vb = fin && qhalf ? lds + AT_V2 : lds + AT_V0 + cur * AT_VB;
            const int ttype = fin ? (qhalf ? 2 : 1) : stype;
            const int cls = fin ? ((qhalf ? hasn : hasp) ? 1 : 2) : (stype == 0 ? 0 : (ste == qhalf ? 1 : 0));
            if (cls != 2) {
#pragma unroll
            for (int qt = 0; qt < 2; ++qt) {
                f32x16 st[2];
                const bool deado = cls == 1 && ((ttype == 1) == (qt == 1));
#pragma unroll
                for (int kt = 0; kt < 2; ++kt) {
                    if (kt != qt && deado) {
#pragma unroll
                        for (int i = 0; i < 16; ++i) st[kt][i] = NEG;
                    } else {
#pragma unroll
                        for (int i = 0; i < 16; ++i) st[kt][i] = -m[qt];
#pragma unroll
                        for (int ds = 0; ds < 4; ++ds) { const bf16x8 kf = *(const LAS bf16x8*)(Kb + krd + kt * (32 * 144) + ds * 32);
                            const bf16x8 qf = *(const LAS bf16x8*)(Qw + krd + qt * (32 * 144) + ds * 32);
                            st[kt] = __builtin_amdgcn_mfma_f32_32x32x16_bf16(kf, qf, st[kt], 0, 0, 0); }
                    }
                }
                if (cls == 1) {
                    const int thr = r - 4 * hi;
                    if (ttype == 1) {
#pragma unroll
                        for (int i = 0; i < 16; ++i) { const int ci = (i & 3) + 8 * (i >> 2); st[qt][i] = ci >= thr ? st[qt][i] : NEG; }
                    } else {
#pragma unroll
                        for (int i = 0; i < 16; ++i) { const int ci = (i & 3) + 8 * (i >> 2); st[qt][i] = ci <= thr ? st[qt][i] : NEG; }
                    }
                }
                float mt = fmaxf(fmaxf(st[0][0], st[0][1]), st[1][0]);
#pragma unroll
                for (int i = 2; i < 16; i += 2) mt = fmaxf(fmaxf(mt, st[0][i]), st[0][i + 1]);
#pragma unroll
                for (int i = 1; i < 15; i += 2) mt = fmaxf(fmaxf(mt, st[1][i]), st[1][i + 1]);
                mt = fmaxf(mt, st[1][15]);
                mt = fmaxf(mt, __shfl_xor(mt, 32));
                if (__any(mt > 8.f)) {
                    const float dl = fmaxf(mt, 0.f), alpha = __builtin_amdgcn_exp2f(-dl); m[qt] += dl; l[qt] *= alpha;
#pragma unroll
                    for (int kt = 0; kt < 2; ++kt)
#pragma unroll
                        for (int i = 0; i < 16; ++i) st[kt][i] -= dl;
#pragma unroll
                    for (int dh = 0; dh < 2; ++dh)
#pragma unroll
                        for (int i = 0; i < 16; ++i) ot[dh][qt][i] *= alpha; }
                f32x2_t ps2 = {0.f, 0.f};
                u32x4 pf[2][2];
#pragma unroll
                for (int kt = 0; kt < 2; ++kt) {
                    if (kt != qt && deado) continue;
#pragma unroll
                    for (int i = 0; i < 16; i += 2) { f32x2_t p; p.x = __builtin_amdgcn_exp2f(st[kt][i]); p.y = __builtin_amdgcn_exp2f(st[kt][i + 1]); st[kt][i] = p.x; st[kt][i + 1] = p.y; ps2 = ps2 + p; }
#pragma unroll
                    for (int s = 0; s < 2; ++s)
#pragma unroll
                        for (int j = 0; j < 4; ++j) pf[kt][s][j] = cvtpk(st[kt][8 * s + 2 * j], st[kt][8 * s + 2 * j + 1]);
                }
                l[qt] += ps2.x + ps2.y;
#pragma unroll
                for (int dh = 0; dh < 2; ++dh)
#pragma unroll
                    for (int kt = 0; kt < 2; ++kt) {
                        if (kt != qt && deado) continue;
#pragma unroll
                        for (int s = 0; s < 2; ++s) { const LAS unsigned char* vpn = Vb + vrd + dh * 4096 + (2 * kt + s) * 1024;
                            const s16x4 lo = tr16(vpn), hh = tr16(vpn + 512);
                            const bf16x8 vf = (bf16x8){lo[0], lo[1], lo[2], lo[3], hh[0], hh[1], hh[2], hh[3]};
                            ot[dh][qt] = __builtin_amdgcn_mfma_f32_32x32x16_bf16(vf, __builtin_bit_cast(bf16x8, pf[kt][s]), ot[dh][qt], 0, 0, 0); } }
                __builtin_amdgcn_sched_barrier(0);
            }
            }
            if (t + 1 < NT) { *(LAS u32x4*)(lds + AT_K0 + (cur ^ 1) * AT_KB + kwr) = kreg; *(LAS u32x4*)(lds + AT_V0 + (cur ^ 1) * AT_VB + vwr) = vreg; }
            if (nfin) { *(LAS u32x4*)(lds + AT_K2 + kwr) = kreg2; *(LAS u32x4*)(lds + AT_V2 + vwr) = vreg2; }
            __syncthreads();
            type = typen; te = ten; typen = typenn; ten = tenn; kreg = kregn; vreg = vregn;
        }
        const float snk = sink[h] * LOG2E;
#pragma unroll
        for (int qt = 0; qt < 2; ++qt) {
            float lt = l[qt] + __shfl_xor(l[qt], 32); lt += __builtin_amdgcn_exp2f(snk - m[qt]);
            const float inv = 1.f / lt;
#pragma unroll
            for (int dh = 0; dh < 2; ++dh)
#pragma unroll
                for (int g4 = 0; g4 < 4; ++g4) { u32x2 w; w.x = cvtpk(ot[dh][qt][4 * g4] * inv, ot[dh][qt][4 * g4 + 1] * inv); w.y = cvtpk(ot[dh][qt][4 * g4 + 2] * inv, ot[dh][qt][4 * g4 + 3] * inv);
                    *(LAS u32x2*)(Qw + (qt * 32 + r) * 144 + (dh * 32 + 8 * g4 + 4 * hi) * 2) = w; }
        }
        asm volatile("s_waitcnt lgkmcnt(0)" ::: "memory");
#pragma unroll
        for (int i = 0; i < 8; ++i) { const u32x4 w = *(const LAS u32x4*)(Qw + (i * 8 + (lane >> 3)) * 144 + (lane & 7) * 16);
            *(u32x4*)(O + (qrow0 + i * 8 + (lane >> 3)) * 1024 + h * 64 + (lane & 7) * 8) = w; }
        asm volatile("s_waitcnt lgkmcnt(0)" ::: "memory");
    }
}

#define XB_TMO      128
#define XB_XCNT(j)  (256  + 64 * (j))
#define XB_XSUB(j)  (1280 + 64 * (j))
#define XB_XGEN(j)  (2304 + 64 * (j))
#define XB_TOP      3328
#define XB_TOPGEN   3392
#define XCD_BAR_WORDS 3456
#define XB_SPIN_CAP (1u << 18)

__device__ __forceinline__ unsigned xb_ld(unsigned* p)              { return __hip_atomic_load(p, __ATOMIC_RELAXED, __HIP_MEMORY_SCOPE_AGENT); }
__device__ __forceinline__ unsigned xb_add(unsigned* p, unsigned v) { return __hip_atomic_fetch_add(p, v, __ATOMIC_RELAXED, __HIP_MEMORY_SCOPE_AGENT); }
__device__ __forceinline__ unsigned xb_xcc_id() { return (unsigned)__builtin_amdgcn_s_getreg((3 << 11) | 20) & 0xFu; }
#define XB_SPIN(cond, bar) do { unsigned _sp = 0; while (cond) { __builtin_amdgcn_s_sleep(1); \
    if ((++_sp & 255u) == 0u) { if (xb_ld(&(bar)[XB_TMO])) break; if (_sp > XB_SPIN_CAP) { atomicAdd(&(bar)[XB_TMO], 1u); break; } } } } while (0)

struct XcdBarrier {
    unsigned* bar; unsigned x;
    volatile LAS unsigned* st;
};

__device__ __forceinline__ XcdBarrier xcd_barrier_post(unsigned* bar, volatile LAS unsigned* st) {
    XcdBarrier b; b.bar = bar; b.x = xb_xcc_id(); b.st = st;
    if (tid_hw() == 0) (void)xb_add(&bar[XB_XCNT(b.x)], 1u);
    return b;
}
__device__ __forceinline__ void xcd_barrier_complete(unsigned* bar, unsigned x, unsigned& nloc, unsigned& nx) {
    const unsigned G = gridDim.x * gridDim.y * gridDim.z;
    unsigned sum, cnt, mine, sp = 0u;
    for (;;) {
        sum = 0u; cnt = 0u; mine = 0u;
#pragma unroll
        for (unsigned j = 0; j < 16; ++j) { const unsigned c = xb_ld(&bar[XB_XCNT(j)]); sum += c; cnt += (c > 0u) ? 1u : 0u; mine = (j == x) ? c : mine; }
        if (sum == G) break;
        __builtin_amdgcn_s_sleep(1);
        if ((++sp & 255u) == 0u) { if (xb_ld(&bar[XB_TMO])) break; if (sp > XB_SPIN_CAP) { atomicAdd(&bar[XB_TMO], 1u); break; } }
    }
    nloc = mine > 0u ? mine : 1u; nx = cnt > 0u ? cnt : 1u;
}

__device__ __forceinline__ void xcd_barrier(const XcdBarrier& b) {
    asm volatile("s_waitcnt vmcnt(0)" ::: "memory");
    __syncthreads();
    if (tid_hw() == 0) {
        unsigned* bar = b.bar;
        __builtin_amdgcn_s_waitcnt(0);
        unsigned nloc = b.st[0], nx = b.st[1];
        if (nloc == 0u) { xcd_barrier_complete(bar, b.x, nloc, nx); b.st[0] = nloc; b.st[1] = nx; }
        const unsigned old = xb_add(&bar[XB_XSUB(b.x)], 1u);
        const unsigned gen = old / nloc;
        if (old + 1u == (gen + 1u) * nloc) {
            __builtin_amdgcn_fence(__ATOMIC_RELEASE, "agent");
            asm volatile("s_waitcnt vmcnt(0)" ::: "memory");
            const unsigned og = xb_add(&bar[XB_TOP], 1u);
            const unsigned tg = og / nx;
            if (og + 1u == (tg + 1u) * nx) xb_add(&bar[XB_TOPGEN], 1u);
            else XB_SPIN(xb_ld(&bar[XB_TOPGEN]) == tg, bar);
            __builtin_amdgcn_fence(__ATOMIC_ACQUIRE, "agent");
            xb_add(&bar[XB_XGEN(b.x)], 1u);
            asm volatile("s_waitcnt vmcnt(0)" ::: "memory");
        } else {
            XB_SPIN(xb_ld(&bar[XB_XGEN(b.x)]) == gen, bar);
            __builtin_amdgcn_fence(__ATOMIC_ACQUIRE, "agent");
            asm volatile("s_waitcnt vmcnt(0)" ::: "memory");
        }
    }
    __syncthreads();
}

#define GRID_SYNC() xcd_barrier(xb)
#ifndef SG_REP
#define SG_REP
#endif
template <class Epi> DI void run_gemm(LAS unsigned char* lds, const bf16_t* A, const bf16_t* Bt, int M, int N, int K, const Epi& E, int G) {
    pg8::Gemm g{A, Bt, M, N, K, K}; pg8::StaticOrder S; S.init(M, N, G, (int)blockIdx.x);
    pg8::gemm_phase<Epi, pg8::StaticOrder, true, true>(lds, g, S, E);
}

DI void run_gemm_ctx_splitk(LAS unsigned char* lds, const bf16_t* A  , const bf16_t* Bt  , int K, bf16_t* slab, int G) {
    const int nt = K / 64; const int nt0 = ((nt + 3) / 4 + 1) & ~1, nt1 = (nt - 2 * nt0) / 2;
    for (int w = blockIdx.x; w < 256; w += G) {
        const int sl = w >> 6, un = w & 63, pm = un >> 2, pn = un & 3;
        const int kt0 = sl < 2 ? sl * nt0 : 2 * nt0 + (sl - 2) * nt1, ntl = sl < 2 ? nt0 : nt1;
        pg8::Gemm g{A + (size_t)(pm * 256) * K + kt0 * 64, Bt + (size_t)(pn * 256) * K + kt0 * 64, 256, 256, ntl * 64, K};
        pg8::EpiBf16 E{slab + (size_t)sl * MCTX * D + (size_t)(pm * 256) * D + pn * 256, D, 0, 0};
        pg8::gemm_phase<pg8::EpiBf16, pg8::OneUnit, false, true>(lds, g, pg8::OneUnit{}, E);
    }
}


struct DstPlain { bf16_t* C; int ldc; DI bf16_t* at(int row, int col) const { return C + (size_t)row * ldc + col; } };
struct DstKV { bf16_t *Kc, *Vc; DI bf16_t* at(int row, int col) const { return col < 256 ? Kc + (size_t)row * 256 + col : Vc + (size_t)row * 256 + (col - 256); } };
template <int WM, int WN, int KS, int NW, class Dst>
DI void small_gemm(const bf16_t* __restrict__ A, const bf16_t* __restrict__ Bt, int M, int N, LAS unsigned char* lds, int vcu, int G, const Dst& dst) {
    constexpr int TR = 32 * WM, TC = 32 * WN * NW, CPR = KS / 8, RSTR = KS * 2 + 16, RPS = NTHREADS / CPR, NL = (TR + TC) / RPS, NS = D / KS;
    static_assert(WM * WN == NWAVES && TR % RPS == 0 && TC % RPS == 0 && (TR + TC) * RSTR <= LDS_BYTES - 64, "small_gemm shape");
    const int tid = tid_fresh(), w = tid >> 6, lane = tid & 63, l31 = lane & 31, hi = lane >> 5, wm = w % WM, wn = w / WM;
    const int nct = N / TC, njobs = (M / TR) * nct;
    const int lrow = tid / CPR, lch = tid % CPR;
    LAS unsigned char* wr = lds + lrow * RSTR + lch * 16;
    const LAS unsigned char* fa = lds + (32 * wm + l31) * RSTR + hi * 16;
    const LAS unsigned char* fb = lds + (TR + 32 * NW * wn + l31) * RSTR + hi * 16;
    __syncthreads();
    for (int j = vcu; j < njobs; j += G) {
        const int r0 = (j / nct) * TR, c0 = (j % nct) * TC;
        const bf16_t* pa = A + (size_t)(r0 + lrow) * D + lch * 8;
        const bf16_t* pb = Bt + (size_t)(c0 + lrow) * D + lch * 8;
        u32x4 pre[2][NL];
#pragma unroll
        for (int p = 0; p < 2; ++p)
#pragma unroll
            for (int i = 0; i < NL; ++i) pre[p][i] = *(const u32x4*)((RPS * i < TR ? pa + (size_t)(RPS * i) * D : pb + (size_t)(RPS * i - TR) * D) + p * KS);
        f32x16 acc[NW];
#pragma unroll
        for (int n = 0; n < NW; ++n)
#pragma unroll
            for (int i = 0; i < 16; ++i) acc[n][i] = 0.f;
#pragma unroll
        for (int st = 0; st < NS; ++st) {
#pragma unroll
            for (int i = 0; i < NL; ++i) *(LAS u32x4*)(wr + RPS * i * RSTR) = pre[st & 1][i];
            __syncthreads();
            if (st + 2 < NS) {
#pragma unroll
                for (int i = 0; i < NL; ++i) pre[st & 1][i] = *(const u32x4*)((RPS * i < TR ? pa + (size_t)(RPS * i) * D : pb + (size_t)(RPS * i - TR) * D) + (st + 2) * KS);
            }
#pragma unroll
            for (int s0 = 0; s0 < KS / 16; s0 += 8 / NW) {
                bf16x8 af[8 / NW], bf[8 / NW][NW];
#pragma unroll
                for (int s = 0; s < 8 / NW; ++s) { af[s] = *(const LAS bf16x8*)(fa + (s0 + s) * 32);
#pragma unroll
                    for (int n = 0; n < NW; ++n) bf[s][n] = *(const LAS bf16x8*)(fb + n * 32 * RSTR + (s0 + s) * 32); }
#pragma unroll
                for (int s = 0; s < 8 / NW; ++s)
#pragma unroll
                    for (int n = 0; n < NW; ++n) acc[n] = __builtin_amdgcn_mfma_f32_32x32x16_bf16(af[s], bf[s][n], acc[n], 0, 0, 0);
            }
            __syncthreads();
        }
        const size_t ldc = (size_t)(dst.at(1, 0) - dst.at(0, 0));
#pragma unroll
        for (int n = 0; n < NW; ++n) { bf16_t* cp = dst.at(r0 + 32 * wm + 4 * hi, c0 + 32 * (NW * wn + n) + l31);
#pragma unroll
            for (int i = 0; i < 16; ++i) cp[(size_t)((i & 3) + 8 * (i >> 2)) * ldc] = (bf16_t)f2bf(acc[n][i]); }
    }
}

__global__ void __launch_bounds__(NTHREADS, 2) mega_fwd(Args a) {
    LAS unsigned char* lds = (LAS unsigned char*)lds_raw;
    const int G = gridDim.x; const int bx = blockIdx.x; const int vcu = (G % 8 == 0) ? (bx % 8) * (G / 8) + bx / 8 : bx;
    unsigned char* ws = a.ws; float* out = a.out;
    float* mods = (float*)(ws + WS_MODS); float* xctx = (float*)(ws + WS_XCTX);
    bf16_t* U = (bf16_t*)(ws + WS_U); bf16_t* F = (bf16_t*)(ws + WS_F); bf16_t* Y = (bf16_t*)(ws + WS_Y); bf16_t* H = (bf16_t*)(ws + WS_H);
    bf16_t* Of = (bf16_t*)a.out; bf16_t* Ob = U; bf16_t* XB = (bf16_t*)(ws + WS_XB);
    const float* ng = a.norm_g;
    volatile LAS unsigned* MISC = (volatile LAS unsigned*)(lds + LDS_BYTES - 64);
    if (threadIdx.x == 0) { MISC[0] = 0u; MISC[1] = 0u; }
    if ((threadIdx.x & 63) == 0) ((volatile LAS unsigned char*)lds)[LDS_WID_TAB + hwslot_()] = (unsigned char)(threadIdx.x >> 6);
    __syncthreads();
    XcdBarrier xb = xcd_barrier_post((unsigned*)(ws + WS_BAR), MISC);

    phase_convert(a, lds, vcu, G); __syncthreads(); phase_adaln(a, lds, vcu, G); __syncthreads();
    GRID_SYNC();
    { RowArgs r{}; r.xold_lat = a.x; r.xold_ctx = a.ctx; r.u = U; r.gU = ng + 0 * D; r.modsU = mods; r.sidx = 0; r.nrows = MALL; phase_rows(r, vcu, G); }
    GRID_SYNC();
    run_gemm(lds, U, (const bf16_t*)(ws + WS_WRI), MALL, F_LR, D, pg8::EpiRecIn{F, NF, 0, (const float*)(ws + WS_LB), a.rec_b_g2}, G);
    small_gemm<8, 1, 128, 1>(U, (const bf16_t*)(ws + WS_WRI) + (size_t)F_LR * D, MALL, 32, lds, vcu, G, DstPlain{F + F_LR, NF});
    GRID_SYNC();
    for (int task = bx; task < 256; task += G) {
        const int id = task >> 1, dir = id & 1, hh = (id >> 1) & 3, b = id >> 3;
        if (task & 1) scan_mfma_task<64>(b, hh, dir, F, dir ? Ob : Of, a.rec_w_g2, a.rec_b_g2, lds);
        else scan_mfma_task<128>(b, hh, dir, F, dir ? Ob : Of, a.rec_w_g2, a.rec_b_g2, lds);
        __syncthreads();
    }
    GRID_SYNC();
    phase_combine(Of, Ob, F, a.gn_a, a.gn_b, Ob, vcu, G);
    GRID_SYNC();
    run_gemm(lds, Ob, (const bf16_t*)(ws + WS_WRO), MLAT, D, D, pg8::EpiBf16{Y, D, 0, 0}, G);
    small_gemm<4, 2, 128, 2>(Ob + (size_t)MLAT * D, (const bf16_t*)(ws + WS_WRO), MCTX, D, lds, vcu, G, DstPlain{Y + (size_t)MLAT * D, D});
    GRID_SYNC();
    { RowArgs r{}; r.xold_lat = a.x; r.xold_ctx = a.ctx; r.xnew_b = XB; r.y = Y; r.u = U; r.gY = ng + 1 * D; r.gU = ng + 2 * D; r.mods = mods; r.modsU = mods; r.gidx = 2; r.sidx = 3; r.nrows = MALL; phase_rows(r, vcu, G); }
    GRID_SYNC();
    run_gemm(lds, U, (const bf16_t*)(ws + WS_WFI0), MALL, 2 * FFH, D, pg8::EpiSwiglu{H, FFH, 0}, G);
    GRID_SYNC();
    run_gemm(lds, H, (const bf16_t*)(ws + WS_WFO0), MLAT, D, FFH, pg8::EpiBf16{Y, D, 0, 0}, G);
    run_gemm_ctx_splitk(lds, H + (size_t)MLAT * FFH, (const bf16_t*)(ws + WS_WFO0), FFH, (bf16_t*)a.out, G);
    GRID_SYNC();
    { RowArgs r{}; r.xold_b = XB; r.xnew_b = XB; r.y = Y; r.yslab = (const bf16_t*)a.out; r.u = U; r.gY = ng + 3 * D; r.gU = ng + 4 * D; r.mods = mods; r.modsU = mods + 17 * 6144; r.gidx = 5; r.sidx = 0; r.nrows = MALL; phase_rows(r, vcu, G); }
    GRID_SYNC();
    bf16_t* Qb = (bf16_t*)(ws + WS_Q); bf16_t* Kb = (bf16_t*)(ws + WS_K); bf16_t* Vb = (bf16_t*)(ws + WS_V); bf16_t* Kc = (bf16_t*)(ws + WS_KC); bf16_t* Vc = (bf16_t*)(ws + WS_VC); bf16_t* Oa = (bf16_t*)(ws + WS_O);
    run_gemm(lds, U, (const bf16_t*)(ws + WS_WQKV), MLAT, 1536, D, pg8::EpiQKV{Qb, Kb, Vb, (const float*)(ws + WS_ROPE)}, G);
    SG_REP small_gemm<4, 2, 256, 1>(U + (size_t)MLAT * D, (const bf16_t*)(ws + WS_WQKV) + (size_t)1024 * D, MCTX, 512, lds, vcu, G, DstKV{Kc, Vc});
    GRID_SYNC();
    attn_phase(Qb, Kb, Vb, Kc, Vc, a.att_sink, Oa, lds, vcu, G);
    GRID_SYNC();
    run_gemm(lds, Oa, (const bf16_t*)(ws + WS_WO), MLAT, D, D, pg8::EpiBf16{Y, D, 0, 0}, G);
    GRID_SYNC();
    { RowArgs r{}; r.xold_b = XB; r.xnew_b = XB; r.y = Y; r.u = U; r.gY = ng + 5 * D; r.gU = ng + 6 * D; r.mods = mods + 17 * 6144; r.modsU = mods + 17 * 6144; r.gidx = 2; r.sidx = 3; r.nrows = MLAT; phase_rows(r, vcu, G); }
    GRID_SYNC();
    run_gemm(lds, U, (const bf16_t*)(ws + WS_WFI1), MLAT, 2 * FFH, D, pg8::EpiSwiglu{H, FFH, 0}, G);
    GRID_SYNC();
    run_gemm(lds, H, (const bf16_t*)(ws + WS_WFO1), MLAT, D, FFH, pg8::EpiBf16{Y, D, 0, 0}, G);
    GRID_SYNC();
    { RowArgs r{}; r.xold_b = XB; r.xnew_lat = out; r.y = Y; r.gY = ng + 7 * D; r.mods = mods + 17 * 6144; r.gidx = 5; r.nrows = MLAT; phase_rows(r, vcu, G); }
}

extern "C" void kernel_launch(void* const* d_in, const int* in_sizes, int n_in, void* d_out, int out_size, void* d_ws, size_t ws_size, hipStream_t stream) {
    static int grid = 0;
    if (grid == 0) {
        if (n_in != 19 || out_size != MLAT * D || ws_size < WS_END) { fprintf(stderr, "kernel_launch: unexpected sizes n_in %d out %d ws %zu\n", n_in, out_size, ws_size); grid = -1; return; }
        int dev = 0, cus = 0, per_cu = 0;
        hipGetDevice(&dev); hipDeviceGetAttribute(&cus, hipDeviceAttributeMultiprocessorCount, dev);
        if (hipFuncSetAttribute((const void*)mega_fwd, hipFuncAttributeMaxDynamicSharedMemorySize, LDS_BYTES) != hipSuccess) { fprintf(stderr, "kernel_launch: hipFuncSetAttribute failed\n"); grid = -1; return; }
        if (hipOccupancyMaxActiveBlocksPerMultiprocessor(&per_cu, (const void*)mega_fwd, NTHREADS, LDS_BYTES) != hipSuccess || per_cu < 1) { fprintf(stderr, "kernel_launch: occupancy query says %d blocks per CU\n", per_cu); grid = -1; return; }
        grid = cus;
        fprintf(stderr, "kernel_launch: %d CUs, occupancy %d per CU, grid %d\n", cus, per_cu, grid);
    }
    if (grid < 0) return;
    Args a{};
    a.x = (const float*)d_in[0]; a.c = (const float*)d_in[1]; a.ctx = (const float*)d_in[2]; a.c_ctx = (const float*)d_in[3]; a.ada_w = (const float*)d_in[4]; a.ada_b = (const float*)d_in[5];
    a.norm_g = (const float*)d_in[6]; a.rec_w_in = (const float*)d_in[7]; a.rec_w_out = (const float*)d_in[8]; a.rec_lb = (const float*)d_in[9]; a.rec_w_g2 = (const float*)d_in[10];
    a.rec_b_g2 = (const float*)d_in[11]; a.gn_a = (const float*)d_in[12]; a.gn_b = (const float*)d_in[13]; a.att_w_qkv = (const float*)d_in[14]; a.att_w_o = (const float*)d_in[15];
    a.att_sink = (const float*)d_in[16]; a.ffn_w_in = (const float*)d_in[17]; a.ffn_w_out = (const float*)d_in[18];
    a.out = (float*)d_out; a.ws = (unsigned char*)d_ws;
    if (hipMemsetAsync((char*)d_ws + WS_BAR, 0, WS_BAR_BYTES, stream) != hipSuccess) { fprintf(stderr, "kernel_launch: memset failed\n"); return; }
    void* args[] = {&a};
    hipError_t e = hipLaunchCooperativeKernel((const void*)mega_fwd, dim3(grid), dim3(NTHREADS), args, LDS_BYTES, stream);
    if (e != hipSuccess) fprintf(stderr, "kernel_launch: cooperative launch failed: %s (grid %d)\n", hipGetErrorString(e), grid);
}
```

```cpp
#include <hip/hip_runtime.h>
#include <cstdint>
#include <cstdio>

namespace pg8 {
#define PG8_LAS __attribute__((address_space(3)))
typedef unsigned short bf16_t;
typedef short bf16x8 __attribute__((ext_vector_type(8)));
typedef float f32x4 __attribute__((ext_vector_type(4)));
typedef unsigned u32x4 __attribute__((ext_vector_type(4)));
constexpr int BM = 256, BK = 64, HALF = 128, HTB = HALF * BK * 2  , STAGE_BYTES = 8 * HTB, NXCD = 8, WGM = 4;

__host__ __device__ __forceinline__ int lds_byte(int r, int c) { const int st = (r >> 4) * 2 + (c >> 5), rr = r & 15, cc = c & 31, ob = rr * 64 + cc * 2; return st * 1024 + (ob ^ (((ob >> 9) & 1) << 5)); }
__host__ __device__ __forceinline__ void stage_rc(int b, int& R, int& C) { const int st = b / 1024, sb = b % 1024, swz = sb ^ (((sb >> 9) & 1) << 5); R = (st >> 1) * 16 + swz / 64; C = (st & 1) * 32 + (swz % 64) / 2; }
__host__ __device__ __forceinline__ int perm32(int rho) { const int n = rho >> 4, i = rho & 15; return 8 * (i >> 2) + 4 * n + (i & 3); }

struct Unit { int pm, pn; };
struct Gemm { const bf16_t* A; const bf16_t* Bt; int M, N, K, ld; };

struct StaticOrder {
    int nM, nN, nwg, G, c;
    __host__ __device__ void init(int M, int N, int G_, int c_) { nM = M / BM; nN = N / BM; nwg = nM * nN; G = G_; c = c_; }
    __host__ __device__ bool next(int i, Unit& u) const {
        const long L = (long)i * G + c; if (L >= nwg) return false;
        int wgid = (int)L; { const int q = nwg / NXCD, r = nwg % NXCD, xcd = wgid % NXCD, off = wgid / NXCD; wgid = (xcd < r ? xcd * (q + 1) : r * (q + 1) + (xcd - r) * q) + off; }
        const int nig = WGM * nN, gid = wgid / nig, fm = gid * WGM, gsz = (nM - fm) < WGM ? (nM - fm) : WGM;
        u.pm = fm + ((wgid % nig) % gsz); u.pn = (wgid % nig) / gsz; return true;
    }
    __device__ __forceinline__ void a_ready(const Unit&) const {}
    __device__ __forceinline__ void done(const Unit&) const {}
};


__device__ __forceinline__ unsigned cvt_pk_bf16(float lo, float hi) { unsigned r; asm volatile("v_cvt_pk_bf16_f32 %0, %1, %2" : "=v"(r) : "v"(lo), "v"(hi)); return r; }
typedef float f32x2 __attribute__((ext_vector_type(2)));

struct EpiBf16 {
    static constexpr bool PERM = true, AFTER_DRAIN = false;
    bf16_t* O; int ldc; int split_cols; size_t split_stride;
    __device__ __forceinline__ void operator()(const f32x4 (&acc)[2][2][4][2], const Unit& u, int wr, int wc, int fr, int fq) const {
        const int row0 = u.pm * BM + wr * 64 + fr; int colt = u.pn * BM; bf16_t* base = O;
        if (split_cols) { const int t = colt / split_cols; base += (size_t)t * split_stride; colt -= t * split_cols; }
        const int col0 = colt + wc * 32 + 8 * fq;
#pragma unroll
        for (int ai = 0; ai < 2; ++ai)
#pragma unroll
            for (int m = 0; m < 4; ++m) { bf16_t* rowp = base + (size_t)(row0 + ai * HALF + m * 16) * ldc + col0;
#pragma unroll
                for (int bj = 0; bj < 2; ++bj) { const f32x4 v0 = acc[ai][bj][m][0], v1 = acc[ai][bj][m][1];
                    u32x4 w; w.x = cvt_pk_bf16(v0[0], v0[1]); w.y = cvt_pk_bf16(v0[2], v0[3]); w.z = cvt_pk_bf16(v1[0], v1[1]); w.w = cvt_pk_bf16(v1[2], v1[3]);
                    *(u32x4*)(rowp + bj * HALF) = w; } }
    }
};
__device__ __forceinline__ float silu_fast(float x) { return x * __builtin_amdgcn_rcpf(1.f + __builtin_amdgcn_exp2f(-1.4426950408889634f * x)); }
struct EpiSwiglu {
    static constexpr bool PERM = true, AFTER_DRAIN = false;
    bf16_t* H; int ldh; int pad;
    __device__ __forceinline__ void operator()(const f32x4 (&acc)[2][2][4][2], const Unit& u, int wr, int wc, int fr, int fq) const {
        const int row0 = u.pm * BM + wr * 64 + fr; const int col0 = u.pn * HALF + wc * 32 + 8 * fq;
#pragma unroll
        for (int ai = 0; ai < 2; ++ai)
#pragma unroll
            for (int m = 0; m < 4; ++m) { bf16_t* rowp = H + (size_t)(row0 + ai * HALF + m * 16) * ldh + col0;
                float o[8];
#pragma unroll
                for (int n = 0; n < 2; ++n)
#pragma unroll
                    for (int j = 0; j < 4; ++j) { const float g2 = acc[ai][0][m][n][j]; o[4 * n + j] = (g2 * __builtin_amdgcn_rcpf(1.f + __builtin_amdgcn_exp2f(-g2))) * acc[ai][1][m][n][j]; }
                u32x4 w; w.x = cvt_pk_bf16(o[0], o[1]); w.y = cvt_pk_bf16(o[2], o[3]); w.z = cvt_pk_bf16(o[4], o[5]); w.w = cvt_pk_bf16(o[6], o[7]);
                *(u32x4*)rowp = w; }
    }
};
struct OneUnit { __host__ __device__ bool next(int i, Unit& u) const { if (i > 0) return false; u.pm = 0; u.pn = 0; return true; }
    __device__ __forceinline__ void a_ready(const Unit&) const {} __device__ __forceinline__ void done(const Unit&) const {} };
struct EpiRecIn {
    static constexpr bool PERM = true, AFTER_DRAIN = false;
    bf16_t* O; int ldc; int pad; const float* lb; const float* bg;
    __device__ __forceinline__ void operator()(const f32x4 (&acc)[2][2][4][2], const Unit& u, int wr, int wc, int fr, int fq) const {
        const int row0 = u.pm * BM + wr * 64 + fr; const int colt = u.pn * BM; const int col0 = colt + wc * 32 + 8 * fq;
        const int mode = u.pn < 2 ? 1 : (u.pn < 6 ? 2 : 0);
        float cst[2][8];
#pragma unroll
        for (int bj = 0; bj < 2; ++bj)
#pragma unroll
            for (int j = 0; j < 8; ++j) cst[bj][j] = 0.f;
        if (mode == 2) {
#pragma unroll
            for (int bj = 0; bj < 2; ++bj) { const f32x4 a = *(const f32x4*)(lb + col0 + bj * HALF - 512), b = *(const f32x4*)(lb + col0 + bj * HALF - 512 + 4);
                cst[bj][0] = 1.f - a[0]; cst[bj][1] = 1.f - a[1]; cst[bj][2] = 1.f - a[2]; cst[bj][3] = 1.f - a[3]; cst[bj][4] = 1.f - b[0]; cst[bj][5] = 1.f - b[1]; cst[bj][6] = 1.f - b[2]; cst[bj][7] = 1.f - b[3]; } }
        else if (mode == 3) {
#pragma unroll
            for (int bj = 0; bj < 2; ++bj) { const f32x4 a = *(const f32x4*)(bg + col0 + bj * HALF - 3584), b = *(const f32x4*)(bg + col0 + bj * HALF - 3584 + 4);
                cst[bj][0] = a[0]; cst[bj][1] = a[1]; cst[bj][2] = a[2]; cst[bj][3] = a[3]; cst[bj][4] = b[0]; cst[bj][5] = b[1]; cst[bj][6] = b[2]; cst[bj][7] = b[3]; } }
#pragma unroll
        for (int ai = 0; ai < 2; ++ai)
#pragma unroll
            for (int m = 0; m < 4; ++m) { bf16_t* rowp = O + (size_t)(row0 + ai * HALF + m * 16) * ldc + col0;
#pragma unroll
                for (int bj = 0; bj < 2; ++bj) { float v[8];
#pragma unroll
                    for (int j = 0; j < 4; ++j) { v[j] = acc[ai][bj][m][0][j]; v[4 + j] = acc[ai][bj][m][1][j]; }
                    if (mode == 1) {
#pragma unroll
                        for (int j = 0; j < 8; ++j) v[j] = silu_fast(v[j]) * 0.08838834764831845f; }
                    else if (mode == 2) {
#pragma unroll
                        for (int j = 0; j < 8; ++j) v[j] = cst[bj][j] * __builtin_amdgcn_rcpf(1.f + __builtin_amdgcn_exp2f(1.4426950408889634f * v[j])); }
                    else if (mode == 3) {
#pragma unroll
                        for (int j = 0; j < 8; ++j) { const float x = v[j] + cst[bj][j]; const float e = __builtin_amdgcn_exp2f(-1.4426950408889634f * __builtin_fabsf(x));
                            v[j] = (__builtin_fminf(x, 0.f) * 1.4426950408889634f - __builtin_amdgcn_logf(1.f + e)) * (1.f / 16.f); } }
                    u32x4 w; w.x = cvt_pk_bf16(v[0], v[1]); w.y = cvt_pk_bf16(v[2], v[3]); w.z = cvt_pk_bf16(v[4], v[5]); w.w = cvt_pk_bf16(v[6], v[7]);
                    *(u32x4*)(rowp + bj * HALF) = w; } }
    }
};
struct EpiQKV {
    static constexpr bool PERM = true, AFTER_DRAIN = false;
    bf16_t *Q, *Kd, *V; const float* rope;
    __device__ __forceinline__ void operator()(const f32x4 (&acc)[2][2][4][2], const Unit& u, int wr, int wc, int fr, int fq) const {
        const int row0 = u.pm * BM + wr * 64 + fr; const int i0 = (wc & 1) * 16 + 4 * fq;
#pragma unroll
        for (int ai = 0; ai < 2; ++ai)
#pragma unroll
            for (int m = 0; m < 4; ++m) { const int r = row0 + ai * HALF + m * 16; const int t = r & 2047;
                f32x4 cs = (f32x4){1.f, 1.f, 1.f, 1.f}, sn = (f32x4){0.f, 0.f, 0.f, 0.f};
                if (u.pn < 5) { cs = *(const f32x4*)(rope + t * 32 + i0); sn = *(const f32x4*)(rope + 2048 * 32 + t * 32 + i0); }
#pragma unroll
                for (int bj = 0; bj < 2; ++bj) { const f32x4 v0 = acc[ai][bj][m][0], v1 = acc[ai][bj][m][1]; const int c = u.pn * BM + bj * HALF + wc * 32 + 8 * fq;
                    float o[8];
                    o[0] = v0[0] * cs[0] - v0[1] * sn[0]; o[1] = v0[0] * sn[0] + v0[1] * cs[0]; o[2] = v0[2] * cs[1] - v0[3] * sn[1]; o[3] = v0[2] * sn[1] + v0[3] * cs[1];
                    o[4] = v1[0] * cs[2] - v1[1] * sn[2]; o[5] = v1[0] * sn[2] + v1[1] * cs[2]; o[6] = v1[2] * cs[3] - v1[3] * sn[3]; o[7] = v1[2] * sn[3] + v1[3] * cs[3];
                    const float sc = u.pn < 4 ? 0.125f * 1.4426950408889634f : 1.f;
                    u32x4 w; w.x = cvt_pk_bf16(o[0] * sc, o[1] * sc); w.y = cvt_pk_bf16(o[2] * sc, o[3] * sc); w.z = cvt_pk_bf16(o[4] * sc, o[5] * sc); w.w = cvt_pk_bf16(o[6] * sc, o[7] * sc);
                    bf16_t* dst = u.pn < 4 ? Q + (size_t)r * 1024 + c : (u.pn == 4 ? Kd + (size_t)r * 256 + (c - 1024) : V + (size_t)r * 256 + (c - 1280));
                    *(u32x4*)dst = w; } }
    }
};
template <class Epi, class Sched, bool ALIGN_EPI = false, bool SP2 = false>
__device__ __forceinline__ void gemm_phase(PG8_LAS unsigned char* lds, const Gemm g, const Sched& S, const Epi& E) {
    int tid = threadIdx.x; asm volatile("" : "+v"(tid)); const int wid = __builtin_amdgcn_readfirstlane(tid >> 6), lane = tid & 63, wr = wid >> 2, wc = wid & 3, fr = lane & 15, fq = lane >> 4;
    const int K = g.ld, nt = g.K / BK;
    unsigned voffA[2], voffB[2];
#pragma unroll
    for (int i = 0; i < 2; ++i) { int R, C; stage_rc(tid * 16 + i * 8192, R, C); const int Rb = Epi::PERM ? ((R & ~31) + perm32(R & 31)) : R;
        voffA[i] = (unsigned)(R * K + C) * 2u; voffB[i] = (unsigned)(Rb * K + C) * 2u; }
    const size_t kstep = (size_t)(BK * 2);
    const size_t hstep = (size_t)HALF * K * 2;
    const size_t tstep = 2 * hstep;
    const unsigned ldsw = (unsigned)wid * 1024u;
    const int aoff = lds_byte(wr * 64 + fr, fq * 8), boff = lds_byte(wc * 32 + fr, fq * 8);
#define PG8_SA(b, h) (((b) * 2 + (h)) * HTB)
#define PG8_SB(b, h) ((4 + (b) * 2 + (h)) * HTB)
#define PG8_STAGE(bufoff, gbase, voff) do { _Pragma("unroll") for (int _i = 0; _i < 2; ++_i) \
        __builtin_amdgcn_global_load_lds((const unsigned*)((const char*)(gbase) + (voff)[_i]), (PG8_LAS unsigned*)(lds + (bufoff) + ldsw + _i * 8192), 16, 0, 0); } while (0)
#define PG8_LDA(dst, b, h) do { _Pragma("unroll") for (int m = 0; m < 4; ++m) _Pragma("unroll") for (int k = 0; k < 2; ++k) dst[m][k] = *(const PG8_LAS bf16x8*)(lds + PG8_SA(b, h) + aoff + m * 2048 + k * 1024); } while (0)
#define PG8_LDB(dst, b, h) do { _Pragma("unroll") for (int n = 0; n < 2; ++n) _Pragma("unroll") for (int k = 0; k < 2; ++k) dst[n][k] = *(const PG8_LAS bf16x8*)(lds + PG8_SB(b, h) + boff + n * 2048 + k * 1024); } while (0)
#define PG8_MMA(ai, bj, At, Bt) do { __builtin_amdgcn_s_setprio(1); _Pragma("unroll") for (int m = 0; m < 4; ++m) _Pragma("unroll") for (int n = 0; n < 2; ++n) _Pragma("unroll") for (int k = 0; k < 2; ++k) \
        acc[ai][bj][m][n] = __builtin_amdgcn_mfma_f32_16x16x32_bf16(Bt[n][k], At[m][k], acc[ai][bj][m][n], 0, 0, 0); __builtin_amdgcn_s_setprio(0); } while (0)
#define PG8_WAIT_V(n) asm volatile("s_waitcnt vmcnt(" #n ")" ::: "memory")
#define PG8_WAIT_L(n) asm volatile("s_waitcnt lgkmcnt(" #n ")" ::: "memory")
#define PG8_BAR __builtin_amdgcn_s_barrier()
#define PG8_SCHED __builtin_amdgcn_sched_barrier(0)
    Unit cur, nxt; int ui = 0;
    if (!S.next(0, cur)) return;
    f32x4 acc[2][2][4][2];
#pragma unroll
    for (int a = 0; a < 2; ++a)
#pragma unroll
        for (int b = 0; b < 2; ++b)
#pragma unroll
            for (int m = 0; m < 4; ++m)
#pragma unroll
                for (int n = 0; n < 2; ++n) acc[a][b][m][n] = (f32x4){0.f, 0.f, 0.f, 0.f};
    bf16x8 At[4][2], B0[2][2], B1[2][2];
    const char* cA = (const char*)g.A + (size_t)cur.pm * tstep; const char* cB = (const char*)g.Bt + (size_t)cur.pn * tstep;
    S.a_ready(cur);
    if constexpr (SP2) {
        PG8_STAGE(PG8_SB(0, 0), cB, voffB); PG8_STAGE(PG8_SB(0, 1), cB + hstep, voffB); PG8_STAGE(PG8_SA(0, 0), cA, voffA); PG8_STAGE(PG8_SA(0, 1), cA + hstep, voffA);
        if (wr == 1) PG8_BAR;
        PG8_WAIT_V(2); PG8_BAR;
        PG8_STAGE(PG8_SB(1, 0), cB + kstep, voffB); PG8_STAGE(PG8_SA(1, 0), cA + kstep, voffA); PG8_STAGE(PG8_SB(1, 1), cB + hstep + kstep, voffB);
        PG8_WAIT_V(6); PG8_BAR;
    } else {
        PG8_STAGE(PG8_SB(0, 0), cB, voffB); PG8_STAGE(PG8_SA(0, 0), cA, voffA); PG8_STAGE(PG8_SB(0, 1), cB + hstep, voffB); PG8_STAGE(PG8_SA(0, 1), cA + hstep, voffA);
        if (wr == 1) PG8_BAR;
        PG8_WAIT_V(4); PG8_BAR;
        PG8_STAGE(PG8_SB(1, 0), cB + kstep, voffB); PG8_STAGE(PG8_SA(1, 0), cA + kstep, voffA); PG8_STAGE(PG8_SB(1, 1), cB + hstep + kstep, voffB);
        PG8_WAIT_V(6); PG8_BAR;
    }
    for (;;) {
        const bool has_next = S.next(ui + 1, nxt);
        const char* nA = has_next ? (const char*)g.A + (size_t)nxt.pm * tstep : cA; const char* nB = has_next ? (const char*)g.Bt + (size_t)nxt.pn * tstep : cB;
        for (int t = 0; t < nt; t += 2) {
            const bool last = (t == nt - 2);
            const char* a1 = cA + (size_t)(t + 1) * kstep;
            const char* a2 = last ? nA : cA + (size_t)(t + 2) * kstep; const char* b2 = last ? nB : cB + (size_t)(t + 2) * kstep;
            const char* a3 = a2 + kstep; const char* b3 = b2 + kstep;
            if (last && has_next) S.a_ready(nxt);
            if constexpr (SP2) {
            PG8_LDB(B0, 0, 0); PG8_LDB(B1, 0, 1); PG8_SCHED; PG8_LDA(At, 0, 0); PG8_STAGE(PG8_SA(1, 1), a1 + hstep, voffA);
            PG8_WAIT_V(8); PG8_WAIT_L(0); PG8_BAR; PG8_MMA(0, 0, At, B0); PG8_MMA(0, 1, At, B1); PG8_BAR; PG8_SCHED;
            PG8_LDA(At, 0, 1); PG8_STAGE(PG8_SB(0, 0), b2, voffB); PG8_STAGE(PG8_SB(0, 1), b2 + hstep, voffB); PG8_STAGE(PG8_SA(0, 0), a2, voffA);
            PG8_WAIT_V(8); PG8_WAIT_L(0); PG8_BAR; PG8_MMA(1, 0, At, B0); PG8_MMA(1, 1, At, B1); PG8_BAR; PG8_SCHED;
            PG8_LDB(B0, 1, 0); PG8_LDB(B1, 1, 1); PG8_SCHED; PG8_LDA(At, 1, 0); PG8_STAGE(PG8_SA(0, 1), a2 + hstep, voffA);
            PG8_WAIT_V(8); PG8_WAIT_L(0); PG8_BAR; PG8_MMA(0, 0, At, B0); PG8_MMA(0, 1, At, B1); PG8_BAR; PG8_SCHED;
            PG8_LDA(At, 1, 1); PG8_STAGE(PG8_SB(1, 0), b3, voffB); PG8_STAGE(PG8_SB(1, 1), b3 + hstep, voffB); PG8_STAGE(PG8_SA(1, 0), a3, voffA);
            PG8_WAIT_V(8); PG8_WAIT_L(0); PG8_BAR; PG8_MMA(1, 0, At, B0); PG8_MMA(1, 1, At, B1); PG8_BAR; PG8_SCHED;
            } else {
            PG8_LDB(B0, 0, 0); PG8_SCHED; PG8_LDA(At, 0, 0); PG8_STAGE(PG8_SA(1, 1), a1 + hstep, voffA);
            PG8_WAIT_L(8); PG8_BAR; PG8_WAIT_L(0); PG8_MMA(0, 0, At, B0); PG8_BAR; PG8_SCHED;
            PG8_LDB(B1, 0, 1); PG8_STAGE(PG8_SB(0, 0), b2, voffB);
            PG8_BAR; PG8_WAIT_L(0); PG8_MMA(0, 1, At, B1); PG8_BAR;
            PG8_LDA(At, 0, 1); PG8_STAGE(PG8_SA(0, 0), a2, voffA);
            PG8_BAR; PG8_WAIT_L(0); PG8_MMA(1, 0, At, B0); PG8_BAR; PG8_SCHED;
            PG8_STAGE(PG8_SB(0, 1), b2 + hstep, voffB);
            PG8_WAIT_V(6); PG8_BAR; PG8_MMA(1, 1, At, B1); PG8_BAR;
            PG8_LDB(B0, 1, 0); PG8_SCHED; PG8_LDA(At, 1, 0); PG8_STAGE(PG8_SA(0, 1), a2 + hstep, voffA);
            PG8_WAIT_L(8); PG8_BAR; PG8_WAIT_L(0); PG8_MMA(0, 0, At, B0); PG8_BAR; PG8_SCHED;
            PG8_LDB(B1, 1, 1); PG8_STAGE(PG8_SB(1, 0), b3, voffB);
            PG8_BAR; PG8_WAIT_L(0); PG8_MMA(0, 1, At, B1); PG8_BAR;
            PG8_LDA(At, 1, 1); PG8_STAGE(PG8_SA(1, 0), a3, voffA);
            PG8_BAR; PG8_WAIT_L(0); PG8_MMA(1, 0, At, B0); PG8_BAR; PG8_SCHED;
            PG8_STAGE(PG8_SB(1, 1), b3 + hstep, voffB);
            PG8_WAIT_V(6); PG8_BAR; PG8_MMA(1, 1, At, B1); PG8_BAR;
            }
        }
        if constexpr (ALIGN_EPI) { if (wr == 0) PG8_BAR; }
        if constexpr (!Epi::AFTER_DRAIN) { E(acc, cur, wr, wc, fr, fq); S.done(cur); }
        if (!has_next) break;
#pragma unroll
        for (int a = 0; a < 2; ++a)
#pragma unroll
            for (int b = 0; b < 2; ++b)
#pragma unroll
                for (int m = 0; m < 4; ++m)
#pragma unroll
                    for (int n = 0; n < 2; ++n) acc[a][b][m][n] = (f32x4){0.f, 0.f, 0.f, 0.f};
        cur = nxt; cA = nA; cB = nB; ++ui;
        if constexpr (ALIGN_EPI) { if (wr == 1) PG8_BAR; }
    }
    PG8_WAIT_V(0);
    if constexpr (!ALIGN_EPI) { if (wr == 0) PG8_BAR; }
    PG8_BAR;
    if constexpr (Epi::AFTER_DRAIN) { E.fused(acc, cur, wr, wc, fr, fq, lds, wid, lane); S.done(cur); }
#undef PG8_SA
#undef PG8_SB
#undef PG8_STAGE
#undef PG8_LDA
#undef PG8_LDB
#undef PG8_MMA
#undef PG8_WAIT_V
#undef PG8_WAIT_L
#undef PG8_BAR
#undef PG8_SCHED
}
}


#define DI __device__ __forceinline__
DI int tid_fresh() { int t = threadIdx.x; asm volatile("" : "+v"(t)); return t; }
typedef unsigned short bf16_t;
typedef short bf16x8 __attribute__((ext_vector_type(8)));
typedef float f32x4 __attribute__((ext_vector_type(4)));
typedef unsigned u32x4 __attribute__((ext_vector_type(4)));
typedef unsigned u32x2 __attribute__((ext_vector_type(2)));
#define LAS __attribute__((address_space(3)))

constexpr int D = 1024, NB = 16, T = 2048, LC = 256;
constexpr int MLAT = NB * T, MCTX = NB * LC, MALL = MLAT + MCTX;
constexpr int NF = 4352;
constexpr int FFH = 2816;
constexpr float EPS = 1e-6f;
constexpr int F_AQ = 0, F_AZF = 512, F_AZB = 1024, F_AI = 1536, F_AOG = 2048, F_BQ = 2560, F_BK = 2816, F_BV = 3072, F_BR = 3584, F_LR = 4096;
constexpr int NTHREADS = 512, NWAVES = 8;
constexpr int LDS_BYTES = 147456;

constexpr size_t MiB = 1u << 20;
constexpr size_t WS_BAR = 0, WS_BAR_BYTES = 65536;
constexpr size_t WS_MODS = 1 * MiB;
constexpr size_t WS_ROPE = 2 * MiB;
constexpr size_t WS_LB = 3 * MiB;
constexpr size_t WS_WRI = 4 * MiB;
constexpr size_t WS_WRO = 13 * MiB;
constexpr size_t WS_WQKV = 15 * MiB;
constexpr size_t WS_WO = 18 * MiB;
constexpr size_t WS_WFI0 = 20 * MiB, WS_WFI1 = 31 * MiB;
constexpr size_t WS_WFO0 = 42 * MiB, WS_WFO1 = 48 * MiB;
constexpr size_t WS_XCTX = 56 * MiB;
constexpr size_t WS_U = 72 * MiB;
constexpr size_t WS_F = 144 * MiB;
constexpr size_t WS_Y = 144 * MiB;
constexpr size_t WS_H = 216 * MiB;
constexpr size_t WS_Q = 216 * MiB, WS_K = 280 * MiB, WS_V = 296 * MiB, WS_KC = 312 * MiB, WS_VC = 314 * MiB, WS_O = 316 * MiB;
constexpr size_t WS_XB = 414 * MiB;
constexpr size_t WS_END = 512 * MiB;

DI unsigned f2bf(float f) { unsigned u = __float_as_uint(f); return (u + 0x7fffu + ((u >> 16) & 1u)) >> 16; }
DI float bf2f(unsigned h) { return __uint_as_float(h << 16); }
DI unsigned pk2(float lo, float hi) { return f2bf(lo) | (f2bf(hi) << 16); }
DI float wave_sum(float v) {
#pragma unroll
    for (int o = 1; o < 64; o <<= 1) v += __shfl_xor(v, o);
    return v;
}
DI float sigmoid_f(float x) { return 1.f / (1.f + expf(-x)); }
DI float silu_f(float x) { return x / (1.f + expf(-x)); }
DI float logsigmoid_f(float z) { return fminf(z, 0.f) - log1pf(expf(-fabsf(z))); }

struct Args {
    const float *x, *c, *ctx, *c_ctx, *ada_w, *ada_b, *norm_g, *rec_w_in, *rec_w_out, *rec_lb, *rec_w_g2, *rec_b_g2, *gn_a, *gn_b, *att_w_qkv, *att_w_o, *att_sink, *ffn_w_in, *ffn_w_out;
    float* out; unsigned char* ws;
};

DI void transpose_item(const float* W, int ldw, int src_col0, bf16_t* WT, int K, int dst_row0, int k0, LAS float* scr, int lane, float scale = 1.f) {
#pragma unroll 16
    for (int kk = 0; kk < 64; ++kk) scr[kk * 65 + lane] = W[(size_t)(k0 + kk) * ldw + src_col0 + lane];
    asm volatile("s_waitcnt lgkmcnt(0)" ::: "memory");
    const int c = lane & 7;
#pragma unroll
    for (int j = 0; j < 8; ++j) { const int n = (lane >> 3) + 8 * j; const LAS float* s = scr + (8 * c) * 65 + n;
        u32x4 o; o.x = pk2(s[0 * 65] * scale, s[1 * 65] * scale); o.y = pk2(s[2 * 65] * scale, s[3 * 65] * scale); o.z = pk2(s[4 * 65] * scale, s[5 * 65] * scale); o.w = pk2(s[6 * 65] * scale, s[7 * 65] * scale);
        *(u32x4*)(WT + (size_t)(dst_row0 + n) * K + k0 + 8 * c) = o; }
    asm volatile("s_waitcnt lgkmcnt(0)" ::: "memory");
}
DI void phase_convert(const Args& a, LAS unsigned char* lds, int vcu, int G) {
    const int tidc = tid_fresh(); const int lane = tidc & 63, wid = tidc >> 6;
    LAS float* scr = (LAS float*)(lds + wid * 16640);
    const int gw = vcu * NWAVES + wid, NGW = G * NWAVES;
    constexpr int KB1 = D / 64, KB2 = FFH / 64;
    constexpr int I_RI = (4096 / 64) * KB1, I_RO = (D / 64) * KB1, I_QKV = (1536 / 64) * KB1, I_WO = (D / 64) * KB1, I_FI = (5632 / 64) * KB1, I_FO = (D / 64) * KB2;
    constexpr int NIT = I_RI + I_RO + I_QKV + I_WO + 2 * I_FI + 2 * I_FO;
    for (int it = gw; it < NIT; it += NGW) {
        int r = it;
        if (r < I_RI) { const int nb = r / KB1, kb = r % KB1; const int n0 = nb * 64;
            const int src = n0 < F_BR ? n0 : 3616 + (n0 - F_BR);
            transpose_item(a.rec_w_in, 4128, src, (bf16_t*)(a.ws + WS_WRI), D, n0, kb * 64, scr, lane); continue; }
        r -= I_RI;
        if (r < I_RO) { const int nb = r / KB1, kb = r % KB1; transpose_item(a.rec_w_out, D, nb * 64, (bf16_t*)(a.ws + WS_WRO), D, nb * 64, kb * 64, scr, lane); continue; }
        r -= I_RO;
        if (r < I_QKV) { const int nb = r / KB1, kb = r % KB1; transpose_item(a.att_w_qkv, 1536, nb * 64, (bf16_t*)(a.ws + WS_WQKV), D, nb * 64, kb * 64, scr, lane); continue; }
        r -= I_QKV;
        if (r < I_WO) { const int nb = r / KB1, kb = r % KB1; transpose_item(a.att_w_o, D, nb * 64, (bf16_t*)(a.ws + WS_WO), D, nb * 64, kb * 64, scr, lane); continue; }
        r -= I_WO;
        if (r < 2 * I_FI) { const int l = r / I_FI; r %= I_FI; const int nb = r / KB1, kb = r % KB1;
            const int p = nb >> 2, wq = nb & 3; const int src = wq < 2 ? p * 128 + 64 * wq : FFH + p * 128 + 64 * (wq - 2);
            transpose_item(a.ffn_w_in + (size_t)l * D * 5632, 5632, src, (bf16_t*)(a.ws + (l ? WS_WFI1 : WS_WFI0)), D, nb * 64, kb * 64, scr, lane, wq < 2 ? 1.4426950408889634f : 0.6931471805599453f); continue; }
        r -= 2 * I_FI;
        { const int l = r / I_FO; r %= I_FO; const int nb = r / KB2, kb = r % KB2;
            transpose_item(a.ffn_w_out + (size_t)l * FFH * D, D, nb * 64, (bf16_t*)(a.ws + (l ? WS_WFO1 : WS_WFO0)), FFH, nb * 64, kb * 64, scr, lane); }
    }
    const int gt = vcu * NTHREADS + tidc, NGT = G * NTHREADS;
    for (int it = gt; it < 256 * (D / 8); it += NGT) {
        const int k8 = it % (D / 8), n = it / (D / 8);
        u32x4 w4 = (u32x4){0u, 0u, 0u, 0u};
        if (n < 32) { float o[8];
#pragma unroll
            for (int kk = 0; kk < 8; ++kk) o[kk] = a.rec_w_in[(size_t)(k8 * 8 + kk) * 4128 + 3584 + n];
            w4.x = pk2(o[0], o[1]); w4.y = pk2(o[2], o[3]); w4.z = pk2(o[4], o[5]); w4.w = pk2(o[6], o[7]); }
        *(u32x4*)((bf16_t*)(a.ws + WS_WRI) + (size_t)(F_LR + n) * D + k8 * 8) = w4;
    }
    for (int it = gt; it < T * 32; it += NGT) { const int t = it >> 5, i = it & 31; const int row = t >> 6, col = t & 63;
        const float inv = powf(10000.f, -(float)(2 * (i & 15)) / 32.f); const float ang = (i < 16 ? (float)row : (float)col) * inv;
        float s, c; sincosf(ang, &s, &c); ((float*)(a.ws + WS_ROPE))[it] = c; ((float*)(a.ws + WS_ROPE))[T * 32 + it] = s; }
    for (int it = gt; it < 1024; it += NGT) { const float l0 = a.rec_lb[it], l1 = a.rec_lb[1024 + it]; ((float*)(a.ws + WS_LB))[it] = 1.f / (1.f + expf(l1 - l0)); }
}

DI void phase_adaln(const Args& a, LAS unsigned char* lds, int vcu, int G) {
    LAS float* sc = (LAS float*)lds;
    LAS float* red = (LAS float*)(lds + 17 * 1024 * 4);
    float* mods = (float*)(a.ws + WS_MODS);
    const int tida = tid_fresh(); const int lane = tida & 63, wid = tida >> 6, cx = tida & 15, kg = tida >> 4;
    for (int e = tida; e < 17 * 1024; e += NTHREADS) { const int s = e >> 10, k = e & 1023; const float cv = s < 16 ? a.c[s * D + k] : a.c_ctx[k]; sc[k * 17 + s] = silu_f(cv); }
    __syncthreads();
    for (int item = vcu; item < 256; item += G) {
        const int col0 = item * 48, l = col0 / 6144, j0 = col0 % 6144;
        float acc[3][17];
#pragma unroll
        for (int q = 0; q < 3; ++q)
#pragma unroll
            for (int s = 0; s < 17; ++s) acc[q][s] = 0.f;
        const float* w = a.ada_w + (size_t)l * D * 6144 + j0 + cx;
#pragma unroll 4
        for (int kk = 0; kk < 32; ++kk) { const int k = kg * 32 + kk; const float* wr = w + (size_t)k * 6144;
            const float w0 = wr[0], w1 = wr[16], w2 = wr[32];
#pragma unroll
            for (int s = 0; s < 17; ++s) { const float cv = sc[k * 17 + s]; acc[0][s] += cv * w0; acc[1][s] += cv * w1; acc[2][s] += cv * w2; } }
#pragma unroll
        for (int q = 0; q < 3; ++q)
#pragma unroll
            for (int s = 0; s < 17; ++s) { float v = acc[q][s]; v += __shfl_xor(v, 16); v += __shfl_xor(v, 32); if (lane < 16) red[(wid * 51 + q * 17 + s) * 16 + cx] = v; }
        __syncthreads();
        for (int e = tida; e < 51 * 16; e += NTHREADS) { const int qs = e >> 4, x = e & 15, q = qs / 17, s = qs % 17; float v = 0.f;
#pragma unroll
            for (int g = 0; g < 8; ++g) v += red[(g * 51 + qs) * 16 + x];
            const int j = j0 + q * 16 + x; mods[((size_t)l * 17 + s) * 6144 + j] = v + a.ada_b[l * 6144 + j]; }
        __syncthreads();
    }
}

struct RowArgs {
    const float* xold_lat; const float* xold_ctx;
    float* xnew_lat; float* xnew_ctx;
    const bf16_t* xold_b; bf16_t* xnew_b;
    const bf16_t* y;
    const bf16_t* yslab;
    bf16_t* u;
    const float* gY; const float* gU;
    const float* mods;
    const float* modsU;
    int gidx, sidx, nrows, pad;
};
typedef float f32x2r_t __attribute__((ext_vector_type(2))); typedef __bf16 bf16x2r_t __attribute__((ext_vector_type(2)));
DI unsigned cvtpk_r(float lo, float hi) { f32x2r_t v = {lo, hi}; bf16x2r_t b = __builtin_convertvector(v, bf16x2r_t); return __builtin_bit_cast(unsigned, b); }
DI void ld8f(const float* p, float (&o)[8]) { const f32x4 a = *(const f32x4*)p, b = *(const f32x4*)(p + 4); o[0] = a[0]; o[1] = a[1]; o[2] = a[2]; o[3] = a[3]; o[4] = b[0]; o[5] = b[1]; o[6] = b[2]; o[7] = b[3]; }
DI void ld8b(const bf16_t* p, float (&o)[8]) { const u32x4 w = *(const u32x4*)p;
#pragma unroll
    for (int i = 0; i < 4; ++i) { o[2 * i] = bf2f(w[i] & 0xffffu); o[2 * i + 1] = bf2f(w[i] >> 16); } }
DI u32x4 pk8(const float (&v)[8]) { return (u32x4){cvtpk_r(v[0], v[1]), cvtpk_r(v[2], v[3]), cvtpk_r(v[4], v[5]), cvtpk_r(v[6], v[7])}; }
template <int R>
DI void row_pass(const RowArgs& a, int row0, int rstride, int lane) {
    float x[R][2][8], y[R][2][8]; int rows[R]; bool ok[R];
#pragma unroll
    for (int i = 0; i < R; ++i) { rows[i] = row0 + i * rstride; ok[i] = rows[i] < a.nrows; if (!ok[i]) rows[i] = row0; }
#pragma unroll
    for (int i = 0; i < R; ++i) { const int row = rows[i]; const bool lat = row < MLAT;
#pragma unroll
        for (int j = 0; j < 2; ++j) { const int c = (64 * j + lane) * 8;
            if (a.xold_b) ld8b(a.xold_b + (size_t)row * D + c, x[i][j]);
            else ld8f((lat ? a.xold_lat + (size_t)row * D : a.xold_ctx + (size_t)(row - MLAT) * D) + c, x[i][j]);
            if (a.y) {
                if (a.yslab && !lat) { const bf16_t* ys = a.yslab + (size_t)(row - MLAT) * D + c; float t1[8], t2[8], t3[8];
                    ld8b(ys, y[i][j]); ld8b(ys + (size_t)MCTX * D, t1); ld8b(ys + (size_t)2 * MCTX * D, t2); ld8b(ys + (size_t)3 * MCTX * D, t3);
#pragma unroll
                    for (int e = 0; e < 8; ++e) y[i][j][e] = (y[i][j][e] + t1[e]) + (t2[e] + t3[e]); }
                else ld8b(a.y + (size_t)row * D + c, y[i][j]); } } }
    const int s0 = rows[0] < MLAT ? rows[0] / T : 16;
    float gy[2][8], gt[2][8], gu[2][8], sh[2][8], sc[2][8];
#pragma unroll
    for (int j = 0; j < 2; ++j) { const int c = (64 * j + lane) * 8;
        if (a.y) { ld8f(a.gY + c, gy[j]); ld8f(a.mods + (size_t)s0 * 6144 + a.gidx * D + c, gt[j]); }
        if (a.u) { ld8f(a.gU + c, gu[j]); ld8f(a.modsU + (size_t)s0 * 6144 + a.sidx * D + c, sh[j]); ld8f(a.modsU + (size_t)s0 * 6144 + (a.sidx + 1) * D + c, sc[j]); } }
    if (a.y) {
        float ss[R];
#pragma unroll
        for (int i = 0; i < R; ++i) { ss[i] = 0.f;
#pragma unroll
            for (int j = 0; j < 2; ++j)
#pragma unroll
                for (int e = 0; e < 8; ++e) ss[i] += y[i][j][e] * y[i][j][e]; }
#pragma unroll
        for (int o = 1; o < 64; o <<= 1)
#pragma unroll
            for (int i = 0; i < R; ++i) ss[i] += __shfl_xor(ss[i], o);
#pragma unroll
        for (int i = 0; i < R; ++i) { const int row = rows[i]; const bool lat = row < MLAT;
            const float r = rsqrtf(ss[i] * (1.f / D) + EPS);
#pragma unroll
            for (int j = 0; j < 2; ++j) { const int c = (64 * j + lane) * 8;
#pragma unroll
                for (int e = 0; e < 8; ++e) x[i][j][e] += gt[j][e] * (y[i][j][e] * r * gy[j][e]);
                if (ok[i]) {
                    if (lat ? a.xnew_lat != nullptr : a.xnew_ctx != nullptr) { float* xn = (lat ? a.xnew_lat + (size_t)row * D : a.xnew_ctx + (size_t)(row - MLAT) * D) + c;
                        *(f32x4*)xn = (f32x4){x[i][j][0], x[i][j][1], x[i][j][2], x[i][j][3]}; *(f32x4*)(xn + 4) = (f32x4){x[i][j][4], x[i][j][5], x[i][j][6], x[i][j][7]}; }
                    if (a.xnew_b) { const u32x4 w = pk8(x[i][j]); *(u32x4*)(a.xnew_b + (size_t)row * D + c) = w;
#pragma unroll
                        for (int e = 0; e < 4; ++e) { x[i][j][2 * e] = bf2f(w[e] & 0xffffu); x[i][j][2 * e + 1] = bf2f(w[e] >> 16); } } } }
        }
    }
    if (a.u) {
        float ss[R];
#pragma unroll
        for (int i = 0; i < R; ++i) { ss[i] = 0.f;
#pragma unroll
            for (int j = 0; j < 2; ++j)
#pragma unroll
                for (int e = 0; e < 8; ++e) ss[i] += x[i][j][e] * x[i][j][e]; }
#pragma unroll
        for (int o = 1; o < 64; o <<= 1)
#pragma unroll
            for (int i = 0; i < R; ++i) ss[i] += __shfl_xor(ss[i], o);
#pragma unroll
        for (int i = 0; i < R; ++i) { const int row = rows[i];
            const float r = rsqrtf(ss[i] * (1.f / D) + EPS);
            if (ok[i]) {
#pragma unroll
                for (int j = 0; j < 2; ++j) { const int c = (64 * j + lane) * 8; float o[8];
#pragma unroll
                    for (int e = 0; e < 8; ++e) o[e] = (x[i][j][e] * r * gu[j][e]) * (sc[j][e] + 1.f) + sh[j][e];
                    *(u32x4*)(a.u + (size_t)row * D + c) = pk8(o); } } }
    }
}
DI void phase_rows(const RowArgs& a, int vcu, int G) {
    constexpr int R = 2;
    const int tidr = tid_fresh(); const int lane = tidr & 63; const int gw = vcu * NWAVES + (tidr >> 6), NGW = G * NWAVES;
    for (int row = R * gw; row < a.nrows; row += R * NGW) row_pass<R>(a, row, 1, lane);
}

typedef float f32x16 __attribute__((ext_vector_type(16)));
typedef short s16x4 __attribute__((ext_vector_type(4)));
typedef float f32x2_t __attribute__((ext_vector_type(2))); typedef __bf16 bf16x2_t __attribute__((ext_vector_type(2)));
DI unsigned cvtpk(float lo, float hi) { f32x2_t v = {lo, hi}; bf16x2_t b = __builtin_convertvector(v, bf16x2_t); return __builtin_bit_cast(unsigned, b); }
DI s16x4 tr16(const LAS unsigned char* p) { return __builtin_bit_cast(s16x4, __builtin_amdgcn_ds_read_tr16_b64_v4i16((LAS s16x4*)p)); }
DI int crow(int i, int hi) { return (i & 3) + 8 * (i >> 2) + 4 * hi; }
constexpr float LOG2E = 1.4426950408889634f;
DI int swap23(int q) { return (q & 3) | ((q & 4) << 1) | ((q & 8) >> 1); }
DI int scan_rbase(int b, int dir, int n) { return n < 8 ? MLAT + b * LC + (dir ? LC - 1 - 32 * n : 32 * n) : b * T + (dir ? T - 1 - 32 * (n - 8) : 32 * (n - 8)); }
DI bf16x8 pack8(const f32x16& x, int s) { u32x4 p; p.x = cvtpk(x[8 * s], x[8 * s + 1]); p.y = cvtpk(x[8 * s + 2], x[8 * s + 3]); p.z = cvtpk(x[8 * s + 4], x[8 * s + 5]); p.w = cvtpk(x[8 * s + 6], x[8 * s + 7]); return __builtin_bit_cast(bf16x8, p); }
struct ScanRaw { u32x4 q[2], z[2], v[2]; };
DI float dpp_shr_f(float old, float v, int n) {
    const int o = __builtin_bit_cast(int, old), x = __builtin_bit_cast(int, v); int r;
    switch (n) { case 1: r = __builtin_amdgcn_update_dpp(o, x, 0x111, 0xf, 0xf, false); break; case 2: r = __builtin_amdgcn_update_dpp(o, x, 0x112, 0xf, 0xf, false); break;
                 case 4: r = __builtin_amdgcn_update_dpp(o, x, 0x114, 0xf, 0xf, false); break; default: r = __builtin_amdgcn_update_dpp(o, x, 0x118, 0xf, 0xf, false); break; }
    return __builtin_bit_cast(float, r); }
DI void unpack8(const u32x4& w, float (&o)[8]) {
#pragma unroll
    for (int i = 0; i < 4; ++i) { o[2 * i] = bf2f(w[i] & 0xffffu); o[2 * i + 1] = bf2f(w[i] >> 16); } }
template <int KD>
DI void scan_load(ScanRaw& R, const bf16_t* __restrict__ F, int b, int hh, int dir, int n, int ptid, int lane, int pw) {
    const int rb = scan_rbase(b, dir, n), st = dir ? -1 : 1;
    if (KD == 128) { const int tp = lane & 15, cg = pw * 4 + (lane >> 4);
#pragma unroll
        for (int e = 0; e < 2; ++e) { const bf16_t* f = F + (size_t)(rb + st * (2 * tp + e)) * NF + hh * 128 + cg * 8;
            R.q[e] = *(const u32x4*)(f + F_AQ); R.z[e] = *(const u32x4*)(f + (dir ? F_AZB : F_AZF)); } }
    else { const int cg = ptid >> 5, tok = ptid & 31; const bf16_t* f = F + (size_t)(rb + st * tok) * NF + hh * 64 + cg * 8;
        R.q[0] = *(const u32x4*)(f + F_BQ); R.q[1] = *(const u32x4*)(f + F_BK); }
#pragma unroll
    for (int i = 0; i < 2; ++i) { const int e = ptid + 256 * i, p = e >> 4, vc8 = e & 15;
        R.v[i] = *(const u32x4*)(F + (size_t)(rb + st * p) * NF + (KD == 128 ? F_AI : F_BV) + hh * 128 + 8 * vc8); }
}
template <int KD>
DI void scan_process(const ScanRaw& R, LAS unsigned char* buf, int ptid, int lane, int pw, const LAS float* gx, const float (&cst)[8]) {
    constexpr int QSTR = KD * 2 + 16, QDB = 32 * QSTR, OFF_KE = QDB, OFF_V = 2 * QDB, OFF_DK = OFF_V + 8192;
    if (KD == 128) {
        const int tp = lane & 15, cg = pw * 4 + (lane >> 4);
        float k0[8], k1[8], q0[8], q1[8], inc[8];
        unpack8(R.z[0], k0); unpack8(R.z[1], k1); unpack8(R.q[0], q0); unpack8(R.q[1], q1);
#pragma unroll
        for (int i = 0; i < 8; ++i) inc[i] = (1.f - k0[i]) * (1.f - k1[i]);
#pragma unroll
        for (int d = 1; d < 16; d <<= 1)
#pragma unroll
            for (int i = 0; i < 8; ++i) inc[i] *= dpp_shr_f(1.f, inc[i], d);
        float o0[8], o1[8], e0[8], e1[8], pl[8];
#pragma unroll
        for (int i = 0; i < 8; ++i) { const float ex = dpp_shr_f(1.f, inc[i], 1); pl[i] = __shfl(inc[i], lane | 15);
            const float c0 = ex * (1.f - k0[i]), c1 = inc[i]; const float rp = __builtin_amdgcn_rcpf(pl[i]);
            o0[i] = q0[i] * (c0 * rp); o1[i] = q1[i] * (c1 * rp); e0[i] = k0[i] * (pl[i] * __builtin_amdgcn_rcpf(c0)); e1[i] = k1[i] * (pl[i] * __builtin_amdgcn_rcpf(c1)); }
        LAS unsigned char* p0 = buf + (2 * tp) * QSTR + cg * 16;
        *(LAS u32x4*)p0 = (u32x4){cvtpk(o0[0], o0[1]), cvtpk(o0[2], o0[3]), cvtpk(o0[4], o0[5]), cvtpk(o0[6], o0[7])};
        *(LAS u32x4*)(p0 + QSTR) = (u32x4){cvtpk(o1[0], o1[1]), cvtpk(o1[2], o1[3]), cvtpk(o1[4], o1[5]), cvtpk(o1[6], o1[7])};
        *(LAS u32x4*)(p0 + OFF_KE) = (u32x4){cvtpk(e0[0], e0[1]), cvtpk(e0[2], e0[3]), cvtpk(e0[4], e0[5]), cvtpk(e0[6], e0[7])};
        *(LAS u32x4*)(p0 + OFF_KE + QSTR) = (u32x4){cvtpk(e1[0], e1[1]), cvtpk(e1[2], e1[3]), cvtpk(e1[4], e1[5]), cvtpk(e1[6], e1[7])};
        if (tp == 0) { *(LAS f32x4*)(buf + OFF_DK + cg * 32) = (f32x4){pl[0], pl[1], pl[2], pl[3]}; *(LAS f32x4*)(buf + OFF_DK + cg * 32 + 16) = (f32x4){pl[4], pl[5], pl[6], pl[7]}; }
    } else {
        const int cg = ptid >> 5, tok = ptid & 31;
        float bc[8], q[8], k[8], bl[8];
        unpack8(R.q[0], q); unpack8(R.q[1], k);
#pragma unroll
        for (int i = 0; i < 8; ++i) { const float x = gx[(cg * 8 + i) * 32 + tok] + cst[i]; const float e = __builtin_amdgcn_exp2f(-LOG2E * fabsf(x));
            bc[i] = (fminf(x, 0.f) * LOG2E - __builtin_amdgcn_logf(1.f + e)) * (1.f / 16.f); }
#pragma unroll
        for (int d = 1; d < 16; d <<= 1)
#pragma unroll
            for (int i = 0; i < 8; ++i) bc[i] += dpp_shr_f(0.f, bc[i], d);
#pragma unroll
        for (int i = 0; i < 8; ++i) { const float t0 = __shfl(bc[i], (lane & 32) + 15); if (lane & 16) bc[i] += t0; bl[i] = __shfl(bc[i], lane | 31); }
        float o[8], e[8];
#pragma unroll
        for (int i = 0; i < 8; ++i) { const float w = __builtin_amdgcn_exp2f(bl[i] - bc[i]); e[i] = k[i] * w; o[i] = q[i] * 0.125f * __builtin_amdgcn_rcpf(w); }
        LAS unsigned char* p0 = buf + tok * QSTR + cg * 16;
        *(LAS u32x4*)p0 = (u32x4){cvtpk(o[0], o[1]), cvtpk(o[2], o[3]), cvtpk(o[4], o[5]), cvtpk(o[6], o[7])};
        *(LAS u32x4*)(p0 + OFF_KE) = (u32x4){cvtpk(e[0], e[1]), cvtpk(e[2], e[3]), cvtpk(e[4], e[5]), cvtpk(e[6], e[7])};
        if (tok == 0) { *(LAS f32x4*)(buf + OFF_DK + cg * 32) = (f32x4){__builtin_amdgcn_exp2f(bl[0]), __builtin_amdgcn_exp2f(bl[1]), __builtin_amdgcn_exp2f(bl[2]), __builtin_amdgcn_exp2f(bl[3])};
            *(LAS f32x4*)(buf + OFF_DK + cg * 32 + 16) = (f32x4){__builtin_amdgcn_exp2f(bl[4]), __builtin_amdgcn_exp2f(bl[5]), __builtin_amdgcn_exp2f(bl[6]), __builtin_amdgcn_exp2f(bl[7])}; }
    }
#pragma unroll
    for (int i = 0; i < 2; ++i) { const int e = ptid + 256 * i, p = e >> 4, vc8 = e & 15; *(LAS u32x4*)(buf + OFF_V + (vc8 >> 2) * 2048 + p * 64 + (vc8 & 3) * 16) = R.v[i]; }
}

#define SCAN_BAR() asm volatile("s_waitcnt lgkmcnt(0)\n\ts_barrier" ::: "memory")
DI void scan_store_o(const LAS unsigned char* ob, bf16_t* O, int b, int dir, int n, int ocol0, int tid) {
    const int tok = tid >> 4, pc = tid & 15; const int rb = scan_rbase(b, dir, n), stp = dir ? -1 : 1;
    const u32x4 w = *(const LAS u32x4*)(ob + tok * 272 + pc * 16);
    *(u32x4*)(O + (size_t)(rb + stp * tok) * D + ocol0 + pc * 8) = w;
}
template <int KD>
DI void scan_mfma_task(int b, int hh, int dir, const bf16_t* __restrict__ F, bf16_t* O, const float* w_g2, const float* b_g2, LAS unsigned char* lds) {
    constexpr int NKT = KD / 32, QSTR = KD * 2 + 16, QDB = 32 * QSTR, OFF_KE = QDB, OFF_V = 2 * QDB, OFF_DK = OFF_V + 8192, BUF = OFF_DK + KD * 4, OSTR = 272, OB0 = 2 * BUF, OBB = 32 * OSTR;
    constexpr int NCH = (LC + T) / 32; static_assert(NCH % 6 == 0, "producer loop is unrolled by 6");
    constexpr int GX0 = 73728, GXB = 8192;
    const int tid = tid_fresh(), lane = tid & 63, wid = __builtin_amdgcn_readfirstlane(tid >> 6);
    const int ocol0 = (KD == 128 ? 0 : 512) + hh * 128;
    if (wid < 4) {
        const int vt = wid, r = lane & 31, hi = lane >> 5;
        f32x16 S[NKT];
#pragma unroll
        for (int kt = 0; kt < NKT; ++kt)
#pragma unroll
            for (int i = 0; i < 16; ++i) S[kt][i] = 0.f;
        const unsigned qrd = r * QSTR + hi * 16;
        const unsigned vrd = vt * 2048 + ((lane >> 4) & 1) * 32 + (lane & 3) * 8 + (4 * hi + ((lane & 15) >> 2)) * 64;
        const unsigned ktr = (4 * hi + ((lane & 15) >> 2)) * QSTR + (((lane >> 4) & 1) * 16 + 8 * (lane & 1) + 4 * ((lane >> 1) & 1)) * 2;
        bf16x8 gwB[2]; bf16x8 lrA;
        const int st_ = dir ? -1 : 1;
#define SCAN_LR_LOAD(c) (*(const bf16x8*)(F + (size_t)(scan_rbase(b, dir, (c)) + st_ * r) * NF + F_LR + dir * 16 + 8 * hi))
#define SCAN_GATES(c, LRV) do { f32x16 z_; _Pragma("unroll") for (int i_ = 0; i_ < 16; ++i_) z_[i_] = 0.f; \
            LAS unsigned char* gs_ = lds + GX0 + ((c) & 1) * GXB; \
            _Pragma("unroll") for (int tl_ = 0; tl_ < 2; ++tl_) { const f32x16 gx_ = __builtin_amdgcn_mfma_f32_32x32x16_bf16(LRV, gwB[tl_], z_, 0, 0, 0); \
                _Pragma("unroll") for (int g4_ = 0; g4_ < 4; ++g4_) *(LAS f32x4*)(gs_ + ((tl_ * 32 + r) * 32 + 8 * g4_ + 4 * hi) * 4) = (f32x4){gx_[4 * g4_], gx_[4 * g4_ + 1], gx_[4 * g4_ + 2], gx_[4 * g4_ + 3]}; } } while (0)
        if (KD == 64 && vt == 0) {
#pragma unroll
            for (int tl = 0; tl < 2; ++tl) { float wv[8];
#pragma unroll
                for (int j = 0; j < 8; ++j) wv[j] = w_g2[(size_t)(dir * 16 + 8 * hi + j) * 256 + hh * 64 + tl * 32 + r];
                const u32x4 wp = (u32x4){cvtpk(wv[0], wv[1]), cvtpk(wv[2], wv[3]), cvtpk(wv[4], wv[5]), cvtpk(wv[6], wv[7])}; gwB[tl] = __builtin_bit_cast(bf16x8, wp); }
            const bf16x8 l0 = SCAN_LR_LOAD(0), l1 = SCAN_LR_LOAD(1); lrA = SCAN_LR_LOAD(2);
            SCAN_GATES(0, l0); SCAN_GATES(1, l1);
        }
        SCAN_BAR();
        SCAN_BAR();
        for (int n = 0; n < NCH; ++n) {
            const LAS unsigned char* B0 = lds + (n & 1) * BUF;
            if (KD == 64 && vt == 0 && n + 2 < NCH) { const bf16x8 cur_ = lrA; if (n + 3 < NCH) lrA = SCAN_LR_LOAD(n + 3); SCAN_GATES(n + 2, cur_); }
            if (n > 0) scan_store_o(lds + OB0 + ((n - 1) & 1) * OBB, O, b, dir, n - 1, ocol0, tid);
            { f32x4 dk[NKT][4];
#pragma unroll
              for (int kt = 0; kt < NKT; ++kt)
#pragma unroll
                  for (int g4 = 0; g4 < 4; ++g4) dk[kt][g4] = *(const LAS f32x4*)(B0 + OFF_DK + (kt * 32 + 16 * (g4 >> 1) + 8 * hi + 4 * (g4 & 1)) * 4);
              __builtin_amdgcn_sched_barrier(0);
#pragma unroll
              for (int kt = 0; kt < NKT; ++kt)
#pragma unroll
                  for (int g4 = 0; g4 < 4; ++g4) { S[kt][4 * g4] *= dk[kt][g4][0]; S[kt][4 * g4 + 1] *= dk[kt][g4][1]; S[kt][4 * g4 + 2] *= dk[kt][g4][2]; S[kt][4 * g4 + 3] *= dk[kt][g4][3]; } }
            f32x16 o, sc;
#pragma unroll
            for (int i = 0; i < 16; ++i) { o[i] = 0.f; sc[i] = 0.f; }
            { bf16x8 qd[2 * NKT], ke[2 * NKT];
#pragma unroll
              for (int ks = 0; ks < 2 * NKT; ++ks) { qd[ks] = *(const LAS bf16x8*)(B0 + qrd + ks * 32); ke[ks] = *(const LAS bf16x8*)(B0 + OFF_KE + qrd + ks * 32); }
              __builtin_amdgcn_sched_barrier(0);
#pragma unroll
              for (int kt = 0; kt < NKT; ++kt)
#pragma unroll
                  for (int s2 = 0; s2 < 2; ++s2) { o = __builtin_amdgcn_mfma_f32_32x32x16_bf16(qd[2 * kt + s2], pack8(S[kt], s2), o, 0, 0, 0);
                      sc = __builtin_amdgcn_mfma_f32_32x32x16_bf16(ke[2 * kt + s2], qd[2 * kt + s2], sc, 0, 0, 0); } }
            { s16x4 vlo[2], vhi[2], klo[NKT][2], khi[NKT][2];
#pragma unroll
              for (int s2 = 0; s2 < 2; ++s2) { vlo[s2] = tr16(B0 + OFF_V + vrd + s2 * 1024); vhi[s2] = tr16(B0 + OFF_V + vrd + s2 * 1024 + 512); }
#pragma unroll
              for (int kt = 0; kt < NKT; ++kt)
#pragma unroll
                  for (int s2 = 0; s2 < 2; ++s2) { const LAS unsigned char* kp = B0 + OFF_KE + ktr + kt * 64 + s2 * (16 * QSTR); klo[kt][s2] = tr16(kp); khi[kt][s2] = tr16(kp + 8 * QSTR); }
              __builtin_amdgcn_sched_barrier(0);
#pragma unroll
              for (int i = 0; i < 16; ++i) if (crow(i, hi) > r) sc[i] = 0.f;
              bf16x8 vb[2];
#pragma unroll
              for (int s2 = 0; s2 < 2; ++s2) vb[s2] = (bf16x8){vlo[s2][0], vlo[s2][1], vlo[s2][2], vlo[s2][3], vhi[s2][0], vhi[s2][1], vhi[s2][2], vhi[s2][3]};
#pragma unroll
              for (int s2 = 0; s2 < 2; ++s2) o = __builtin_amdgcn_mfma_f32_32x32x16_bf16(pack8(sc, s2), vb[s2], o, 0, 0, 0);
#pragma unroll
              for (int kt = 0; kt < NKT; ++kt)
#pragma unroll
                  for (int s2 = 0; s2 < 2; ++s2) { const bf16x8 ket = (bf16x8){klo[kt][s2][0], klo[kt][s2][1], klo[kt][s2][2], klo[kt][s2][3], khi[kt][s2][0], khi[kt][s2][1], khi[kt][s2][2], khi[kt][s2][3]};
                      S[kt] = __builtin_amdgcn_mfma_f32_32x32x16_bf16(ket, vb[s2], S[kt], 0, 0, 0); } }
            { LAS unsigned char* ob = lds + OB0 + (n & 1) * OBB + (vt * 32 + r) * 2;
#pragma unroll
              for (int i = 0; i < 16; ++i) *(LAS unsigned short*)(ob + crow(i, hi) * OSTR) = (unsigned short)cvtpk(o[i], o[i]); }
            SCAN_BAR();
        }
        scan_store_o(lds + OB0 + ((NCH - 1) & 1) * OBB, O, b, dir, NCH - 1, ocol0, tid);
#undef SCAN_LR_LOAD
#undef SCAN_GATES
    } else {
        const int ptid = tid - 256, pw = wid - 4;
        ScanRaw r0, r1, r2;
        scan_load<KD>(r0, F, b, hh, dir, 0, ptid, lane, pw);
        scan_load<KD>(r1, F, b, hh, dir, 1, ptid, lane, pw);
        scan_load<KD>(r2, F, b, hh, dir, 2, ptid, lane, pw);
        float cst[8];
#pragma unroll
        for (int i = 0; i < 8; ++i) cst[i] = KD == 64 ? b_g2[dir * 256 + hh * 64 + (ptid >> 5) * 8 + i] : 0.f;
        const LAS float* gx0 = (const LAS float*)(lds + GX0); const LAS float* gx1 = (const LAS float*)(lds + GX0 + GXB);
        SCAN_BAR();
        scan_process<KD>(r0, lds, ptid, lane, pw, gx0, cst);
        SCAN_BAR();
#define SCAN_IT(nn, LD, PR, BOFF) do { if ((nn) > 0) scan_store_o(lds + OB0 + (((nn) - 1) & 1) * OBB, O, b, dir, (nn) - 1, ocol0, tid); \
            if ((nn) + 3 < NCH) scan_load<KD>(LD, F, b, hh, dir, (nn) + 3, ptid, lane, pw); \
            if ((nn) + 1 < NCH) scan_process<KD>(PR, lds + (BOFF), ptid, lane, pw, (BOFF) ? gx1 : gx0, cst); SCAN_BAR(); } while (0)
        for (int n = 0; n < NCH; n += 6) {
            SCAN_IT(n,     r0, r1, BUF);
            SCAN_IT(n + 1, r1, r2, 0);
            SCAN_IT(n + 2, r2, r0, BUF);
            SCAN_IT(n + 3, r0, r1, 0);
            SCAN_IT(n + 4, r1, r2, BUF);
            SCAN_IT(n + 5, r2, r0, 0);
        }
#undef SCAN_IT
        scan_store_o(lds + OB0 + ((NCH - 1) & 1) * OBB, O, b, dir, NCH - 1, ocol0, tid);
    }
}

DI float silu_fastc(float x) { return x * __builtin_amdgcn_rcpf(1.f + __builtin_amdgcn_exp2f(-1.4426950408889634f * x)); }
DI void phase_combine(const bf16_t* Of, const bf16_t* Ob, const bf16_t* __restrict__ F, const float* gn_a, const float* gn_b, bf16_t* Yg, int vcu, int G) {
    const int tidm = tid_fresh(); const int lane = tidm & 63; const int gw = vcu * NWAVES + (tidm >> 6), NGW = G * NWAVES;
    const int c0 = 16 * lane; const int fc = c0 < 512 ? F_AOG + c0 : F_BR + (c0 - 512);
    float gnv[16];
#pragma unroll
    for (int i = 0; i < 16; ++i) gnv[i] = (c0 < 512 ? gn_a : gn_b)[(c0 & 127) + i];
    for (int row0 = 2 * gw; row0 < MALL; row0 += 2 * NGW) {
        u32x4 av[2][2], bv[2][2], gv[2][2];
#pragma unroll
        for (int i = 0; i < 2; ++i) { const size_t row = row0 + i;
            av[i][0] = *(const u32x4*)(Of + row * D + c0); av[i][1] = *(const u32x4*)(Of + row * D + c0 + 8);
            bv[i][0] = *(const u32x4*)(Ob + row * D + c0); bv[i][1] = *(const u32x4*)(Ob + row * D + c0 + 8);
            gv[i][0] = *(const u32x4*)(F + row * NF + fc); gv[i][1] = *(const u32x4*)(F + row * NF + fc + 8); }
#pragma unroll
        for (int i = 0; i < 2; ++i) { const size_t row = row0 + i; float o[16], gt[16]; float ss = 0.f;
#pragma unroll
            for (int h2 = 0; h2 < 2; ++h2)
#pragma unroll
                for (int e = 0; e < 4; ++e) { o[8 * h2 + 2 * e] = bf2f(av[i][h2][e] & 0xffffu) + bf2f(bv[i][h2][e] & 0xffffu); o[8 * h2 + 2 * e + 1] = bf2f(av[i][h2][e] >> 16) + bf2f(bv[i][h2][e] >> 16);
                    gt[8 * h2 + 2 * e] = bf2f(gv[i][h2][e] & 0xffffu); gt[8 * h2 + 2 * e + 1] = bf2f(gv[i][h2][e] >> 16); }
#pragma unroll
            for (int e = 0; e < 16; ++e) ss += o[e] * o[e];
            ss += __shfl_xor(ss, 1); ss += __shfl_xor(ss, 2); ss += __shfl_xor(ss, 4);
            const float r = rsqrtf(ss * (1.f / 128.f) + EPS);
            unsigned wv[8];
#pragma unroll
            for (int e = 0; e < 8; ++e) wv[e] = cvtpk_r(o[2 * e] * r * gnv[2 * e] * silu_fastc(gt[2 * e]), o[2 * e + 1] * r * gnv[2 * e + 1] * silu_fastc(gt[2 * e + 1]));
            *(u32x4*)(Yg + row * D + c0) = (u32x4){wv[0], wv[1], wv[2], wv[3]}; *(u32x4*)(Yg + row * D + c0 + 8) = (u32x4){wv[4], wv[5], wv[6], wv[7]}; }
    }
}

constexpr int AT_KB = 9216, AT_VB = 8192, AT_K0 = 0, AT_V0 = 2 * AT_KB, AT_Q0 = AT_V0 + 2 * AT_VB, AT_K2 = AT_Q0 + 8 * 9216, AT_V2 = AT_K2 + AT_KB;
static_assert(AT_V2 + AT_VB <= LDS_BYTES - 64, "attention LDS");
constexpr int AT_DUMMY_ = 0;

DI void attn_tile_src(int t, int b, int kv, int blk, bool hasp, bool hasn, const bf16_t* Kl, const bf16_t* Vl, const bf16_t* Kc, const bf16_t* Vc, const bf16_t*& kp, const bf16_t*& vp, int& type, int& te) {
    size_t row0; const bf16_t *kb_ = Kl, *vb_ = Vl;
    if (t < 2) { row0 = (size_t)b * T + blk * 128 + t * 64; type = 0; te = 0; }
    else if (t < 6) { row0 = (size_t)b * LC + (t - 2) * 64; kb_ = Kc; vb_ = Vc; type = 0; te = 0; }
    else { const int e = t - 6;
        if (hasp && e == 0) { row0 = (size_t)b * T + (blk - 1) * 128 + 64; type = 1; te = 1; }
        else if (hasn && e == (hasp ? 1 : 0)) { row0 = (size_t)b * T + (blk + 1) * 128; type = 2; te = 0; }
        else { row0 = (size_t)b * T + (hasp ? blk - 1 : blk) * 128; type = 1; te = 0; } }
    kp = kb_ + row0 * 256 + kv * 64; vp = vb_ + row0 * 256 + kv * 64;
}

DI void attn_phase(const bf16_t* __restrict__ Q, const bf16_t* __restrict__ Kl, const bf16_t* __restrict__ Vl, const bf16_t* __restrict__ Kc, const bf16_t* __restrict__ Vc,
                   const float* sink, bf16_t* O, LAS unsigned char* lds, int vcu, int G) {
    const int tid = tid_fresh(), lane = tid & 63, wid = __builtin_amdgcn_readfirstlane(tid >> 6), r = lane & 31, hi = lane >> 5;
    const int skey = tid >> 3, sc = tid & 7;
    const unsigned kwr = skey * 144 + sc * 16, vwr = (sc >> 2) * 4096 + skey * 64 + (sc & 3) * 16;
    const unsigned krd = r * 144 + hi * 16;
    const unsigned vrd = ((lane >> 4) & 1) * 32 + (lane & 3) * 8 + (4 * hi + ((lane & 15) >> 2)) * 64;
    const int g = wid >> 1, qhalf = wid & 1;
    LAS unsigned char* Qw = lds + AT_Q0 + wid * 9216;
    const float NEG = -1e30f;
    for (int unit = vcu; unit < NB * 4 * 16; unit += G) {
        const int blk = unit & 15, kv = (unit >> 4) & 3, b = unit >> 6, h = kv * 4 + g;
        const bool hasp = blk > 0, hasn = blk < 15; const int NT = 7 + (hasp ? 1 : 0) + (hasn ? 1 : 0);
        const size_t qrow0 = (size_t)b * T + blk * 128 + qhalf * 64;
        const bf16_t *kp, *vp; int type, te;
        attn_tile_src(0, b, kv, blk, hasp, hasn, Kl, Vl, Kc, Vc, kp, vp, type, te);
        u32x4 kreg2 = {0u, 0u, 0u, 0u}, vreg2 = {0u, 0u, 0u, 0u};
        u32x4 kreg = *(const u32x4*)(kp + (size_t)skey * 256 + sc * 8), vreg = *(const u32x4*)(vp + (size_t)skey * 256 + sc * 8);
        { u32x4 qv[8];
#pragma unroll
          for (int i = 0; i < 8; ++i) qv[i] = *(const u32x4*)(Q + (qrow0 + i * 8 + (lane >> 3)) * 1024 + h * 64 + (lane & 7) * 8);
#pragma unroll
          for (int i = 0; i < 8; ++i) *(LAS u32x4*)(Qw + (i * 8 + (lane >> 3)) * 144 + (lane & 7) * 16) = qv[i]; }
        *(LAS u32x4*)(lds + AT_K0 + kwr) = kreg; *(LAS u32x4*)(lds + AT_V0 + vwr) = vreg;
        int typen, ten;
        attn_tile_src(1, b, kv, blk, hasp, hasn, Kl, Vl, Kc, Vc, kp, vp, typen, ten);
        kreg = *(const u32x4*)(kp + (size_t)skey * 256 + sc * 8); vreg = *(const u32x4*)(vp + (size_t)skey * 256 + sc * 8);
        u32x4 kregn = kreg, vregn = vreg;
        f32x16 ot[2][2];
#pragma unroll
        for (int dh = 0; dh < 2; ++dh)
#pragma unroll
            for (int qt = 0; qt < 2; ++qt)
#pragma unroll
                for (int i = 0; i < 16; ++i) ot[dh][qt][i] = 0.f;
        float m[2] = {0.f, 0.f}, l[2] = {0.f, 0.f};
        __syncthreads();
        for (int t = 0; t < NT; ++t) {
            const int cur = t & 1; const int stype = type, ste = te; const bool fin = t == NT - 1, nfin = t + 1 == NT - 1, nnfin = t + 2 == NT - 1;
            int typenn = 0, tenn = 0;
            if (t + 2 < NT) { attn_tile_src(t + 2, b, kv, blk, hasp, hasn, Kl, Vl, Kc, Vc, kp, vp, typenn, tenn);
                if (!nnfin || hasp) { kregn = *(const u32x4*)(kp + (size_t)skey * 256 + sc * 8); vregn = *(const u32x4*)(vp + (size_t)skey * 256 + sc * 8); }
                if (nnfin && hasn) { const size_t o2 = ((size_t)b * T + (blk + 1) * 128 + 64 + skey) * 256 + kv * 64 + sc * 8; kreg2 = *(const u32x4*)(Kl + o2); vreg2 = *(const u32x4*)(Vl + o2); } }
            const LAS unsigned char* Kb = fin && qhalf ? lds + AT_K2 : lds + AT_K0 + cur * AT_KB; const LAS unsigned char* Vb = fin && qhalf ? lds + AT_V2 : lds + AT_V0 + cur * AT_VB;
            const int ttype = fin ? (qhalf ? 2 : 1) : stype;
            const int cls = fin ? ((qhalf ? hasn : hasp) ? 1 : 2) : (stype == 0 ? 0 : (ste == qhalf ? 1 : 0));
            if (cls != 2) {
#pragma unroll
            for (int qt = 0; qt < 2; ++qt) {
                f32x16 st[2];
                const bool deado = cls == 1 && ((ttype == 1) == (qt == 1));
#pragma unroll
                for (int kt = 0; kt < 2; ++kt) {
                    if (kt != qt && deado) {
#pragma unroll
                        for (int i = 0; i < 16; ++i) st[kt][i] = NEG;
                    } else {
#pragma unroll
                        for (int i = 0; i < 16; ++i) st[kt][i] = -m[qt];
#pragma unroll
                        for (int ds = 0; ds < 4; ++ds) { const bf16x8 kf = *(const LAS bf16x8*)(Kb + krd + kt * (32 * 144) + ds * 32);
                            const bf16x8 qf = *(const LAS bf16x8*)(Qw + krd + qt * (32 * 144) + ds * 32);
                            st[kt] = __builtin_amdgcn_mfma_f32_32x32x16_bf16(kf, qf, st[kt], 0, 0, 0); }
                    }
                }
                if (cls == 1) {
                    const int thr = r - 4 * hi;
                    if (ttype == 1) {
#pragma unroll
                        for (int i = 0; i < 16; ++i) { const int ci = (i & 3) + 8 * (i >> 2); st[qt][i] = ci >= thr ? st[qt][i] : NEG; }
                    } else {
#pragma unroll
                        for (int i = 0; i < 16; ++i) { const int ci = (i & 3) + 8 * (i >> 2); st[qt][i] = ci <= thr ? st[qt][i] : NEG; }
                    }
                }
                float mt = fmaxf(fmaxf(st[0][0], st[0][1]), st[1][0]);
#pragma unroll
                for (int i = 2; i < 16; i += 2) mt = fmaxf(fmaxf(mt, st[0][i]), st[0][i + 1]);
#pragma unroll
                for (int i = 1; i < 15; i += 2) mt = fmaxf(fmaxf(mt, st[1][i]), st[1][i + 1]);
                mt = fmaxf(mt, st[1][15]);
                mt = fmaxf(mt, __shfl_xor(mt, 32));
                if (__any(mt > 8.f)) {
                    const float dl = fmaxf(mt, 0.f), alpha = __builtin_amdgcn_exp2f(-dl); m[qt] += dl; l[qt] *= alpha;
#pragma unroll
                    for (int kt = 0; kt < 2; ++kt)
#pragma unroll
                        for (int i = 0; i < 16; ++i) st[kt][i] -= dl;
#pragma unroll
                    for (int dh = 0; dh < 2; ++dh)
#pragma unroll
                        for (int i = 0; i < 16; ++i) ot[dh][qt][i] *= alpha; }
                f32x2_t ps2 = {0.f, 0.f};
                u32x4 pf[2][2];
#pragma unroll
                for (int kt = 0; kt < 2; ++kt) {
                    if (kt != qt && deado) continue;
#pragma unroll
                    for (int i = 0; i < 16; i += 2) { f32x2_t p; p.x = __builtin_amdgcn_exp2f(st[kt][i]); p.y = __builtin_amdgcn_exp2f(st[kt][i + 1]); st[kt][i] = p.x; st[kt][i + 1] = p.y; ps2 = ps2 + p; }
#pragma unroll
                    for (int s = 0; s < 2; ++s)
#pragma unroll
                        for (int j = 0; j < 4; ++j) pf[kt][s][j] = cvtpk(st[kt][8 * s + 2 * j], st[kt][8 * s + 2 * j + 1]);
                }
                l[qt] += ps2.x + ps2.y;
#pragma unroll
                for (int dh = 0; dh < 2; ++dh)
#pragma unroll
                    for (int kt = 0; kt < 2; ++kt) {
                        if (kt != qt && deado) continue;
#pragma unroll
                        for (int s = 0; s < 2; ++s) { const LAS unsigned char* vpn = Vb + vrd + dh * 4096 + (2 * kt + s) * 1024;
                            const s16x4 lo = tr16(vpn), hh = tr16(vpn + 512);
                            const bf16x8 vf = (bf16x8){lo[0], lo[1], lo[2], lo[3], hh[0], hh[1], hh[2], hh[3]};
                            ot[dh][qt] = __builtin_amdgcn_mfma_f32_32x32x16_bf16(vf, __builtin_bit_cast(bf16x8, pf[kt][s]), ot[dh][qt], 0, 0, 0); } }
                __builtin_amdgcn_sched_barrier(0);
            }
            }
            if (t + 1 < NT) { *(LAS u32x4*)(lds + AT_K0 + (cur ^ 1) * AT_KB + kwr) = kreg; *(LAS u32x4*)(lds + AT_V0 + (cur ^ 1) * AT_VB + vwr) = vreg; }
            if (nfin) { *(LAS u32x4*)(lds + AT_K2 + kwr) = kreg2; *(LAS u32x4*)(lds + AT_V2 + vwr) = vreg2; }
            __syncthreads();
            type = typen; te = ten; typen = typenn; ten = tenn; kreg = kregn; vreg = vregn;
        }
        const float snk = sink[h] * LOG2E;
#pragma unroll
        for (int qt = 0; qt < 2; ++qt) {
            float lt = l[qt] + __shfl_xor(l[qt], 32); lt += __builtin_amdgcn_exp2f(snk - m[qt]);
            const float inv = 1.f / lt;
#pragma unroll
            for (int dh = 0; dh < 2; ++dh)
#pragma unroll
                for (int g4 = 0; g4 < 4; ++g4) { u32x2 w; w.x = cvtpk(ot[dh][qt][4 * g4] * inv, ot[dh][qt][4 * g4 + 1] * inv); w.y = cvtpk(ot[dh][qt][4 * g4 + 2] * inv, ot[dh][qt][4 * g4 + 3] * inv);
                    *(LAS u32x2*)(Qw + (qt * 32 + r) * 144 + (dh * 32 + 8 * g4 + 4 * hi) * 2) = w; }
        }
        asm volatile("s_waitcnt lgkmcnt(0)" ::: "memory");
#pragma unroll
        for (int i = 0; i < 8; ++i) { const u32x4 w = *(const LAS u32x4*)(Qw + (i * 8 + (lane >> 3)) * 144 + (lane & 7) * 16);
            *(u32x4*)(O + (qrow0 + i * 8 + (lane >> 3)) * 1024 + h * 64 + (lane & 7) * 8) = w; }
        asm volatile("s_waitcnt lgkmcnt(0)" ::: "memory");
    }
}

#define XB_TMO      128
#define XB_XCNT(j)  (256  + 64 * (j))
#define XB_XSUB(j)  (1280 + 64 * (j))
#define XB_XGEN(j)  (2304 + 64 * (j))
#define XB_TOP      3328
#define XB_TOPGEN   3392
#define XCD_BAR_WORDS 3456
#define XB_SPIN_CAP (1u << 18)

__device__ __forceinline__ unsigned xb_ld(unsigned* p)              { return __hip_atomic_load(p, __ATOMIC_RELAXED, __HIP_MEMORY_SCOPE_AGENT); }
__device__ __forceinline__ unsigned xb_add(unsigned* p, unsigned v) { return __hip_atomic_fetch_add(p, v, __ATOMIC_RELAXED, __HIP_MEMORY_SCOPE_AGENT); }
__device__ __forceinline__ unsigned xb_xcc_id() { return (unsigned)__builtin_amdgcn_s_getreg((3 << 11) | 20) & 0xFu; }
#define XB_SPIN(cond, bar) do { unsigned _sp = 0; while (cond) { __builtin_amdgcn_s_sleep(1); \
    if ((++_sp & 255u) == 0u) { if (xb_ld(&(bar)[XB_TMO])) break; if (_sp > XB_SPIN_CAP) { atomicAdd(&(bar)[XB_TMO], 1u); break; } } } } while (0)

struct XcdBarrier {
    unsigned* bar; unsigned x;
    volatile LAS unsigned* st;
};

__device__ __forceinline__ XcdBarrier xcd_barrier_post(unsigned* bar, volatile LAS unsigned* st) {
    XcdBarrier b; b.bar = bar; b.x = xb_xcc_id(); b.st = st;
    if (threadIdx.x == 0) (void)xb_add(&bar[XB_XCNT(b.x)], 1u);
    return b;
}
__device__ __forceinline__ void xcd_barrier_complete(unsigned* bar, unsigned x, unsigned& nloc, unsigned& nx) {
    const unsigned G = gridDim.x * gridDim.y * gridDim.z;
    unsigned sum, cnt, mine, sp = 0u;
    for (;;) {
        sum = 0u; cnt = 0u; mine = 0u;
#pragma unroll
        for (unsigned j = 0; j < 16; ++j) { const unsigned c = xb_ld(&bar[XB_XCNT(j)]); sum += c; cnt += (c > 0u) ? 1u : 0u; mine = (j == x) ? c : mine; }
        if (sum == G) break;
        __builtin_amdgcn_s_sleep(1);
        if ((++sp & 255u) == 0u) { if (xb_ld(&bar[XB_TMO])) break; if (sp > XB_SPIN_CAP) { atomicAdd(&bar[XB_TMO], 1u); break; } }
    }
    nloc = mine > 0u ? mine : 1u; nx = cnt > 0u ? cnt : 1u;
}

__device__ __forceinline__ void xcd_barrier(const XcdBarrier& b) {
    asm volatile("s_waitcnt vmcnt(0)" ::: "memory");
    __syncthreads();
    if (threadIdx.x == 0) {
        unsigned* bar = b.bar;
        __builtin_amdgcn_s_waitcnt(0);
        unsigned nloc = b.st[0], nx = b.st[1];
        if (nloc == 0u) { xcd_barrier_complete(bar, b.x, nloc, nx); b.st[0] = nloc; b.st[1] = nx; }
        const unsigned old = xb_add(&bar[XB_XSUB(b.x)], 1u);
        const unsigned gen = old / nloc;
        if (old + 1u == (gen + 1u) * nloc) {
            __builtin_amdgcn_fence(__ATOMIC_RELEASE, "agent");
            asm volatile("s_waitcnt vmcnt(0)" ::: "memory");
            const unsigned og = xb_add(&bar[XB_TOP], 1u);
            const unsigned tg = og / nx;
            if (og + 1u == (tg + 1u) * nx) xb_add(&bar[XB_TOPGEN], 1u);
            else XB_SPIN(xb_ld(&bar[XB_TOPGEN]) == tg, bar);
            __builtin_amdgcn_fence(__ATOMIC_ACQUIRE, "agent");
            xb_add(&bar[XB_XGEN(b.x)], 1u);
            asm volatile("s_waitcnt vmcnt(0)" ::: "memory");
        } else {
            XB_SPIN(xb_ld(&bar[XB_XGEN(b.x)]) == gen, bar);
            __builtin_amdgcn_fence(__ATOMIC_ACQUIRE, "agent");
            asm volatile("s_waitcnt vmcnt(0)" ::: "memory");
        }
    }
    __syncthreads();
}

#define GRID_SYNC() xcd_barrier(xb)
#ifndef SG_REP
#define SG_REP
#endif
template <class Epi> DI void run_gemm(LAS unsigned char* lds, const bf16_t* A, const bf16_t* Bt, int M, int N, int K, const Epi& E, int G) {
    pg8::Gemm g{A, Bt, M, N, K, K}; pg8::StaticOrder S; S.init(M, N, G, (int)blockIdx.x);
    pg8::gemm_phase<Epi, pg8::StaticOrder, true, true>(lds, g, S, E);
}

DI void run_gemm_ctx_splitk(LAS unsigned char* lds, const bf16_t* A  , const bf16_t* Bt  , int K, bf16_t* slab, int G) {
    const int nt = K / 64; const int nt0 = ((nt + 3) / 4 + 1) & ~1, nt1 = (nt - 2 * nt0) / 2;
    for (int w = blockIdx.x; w < 256; w += G) {
        const int sl = w >> 6, un = w & 63, pm = un >> 2, pn = un & 3;
        const int kt0 = sl < 2 ? sl * nt0 : 2 * nt0 + (sl - 2) * nt1, ntl = sl < 2 ? nt0 : nt1;
        pg8::Gemm g{A + (size_t)(pm * 256) * K + kt0 * 64, Bt + (size_t)(pn * 256) * K + kt0 * 64, 256, 256, ntl * 64, K};
        pg8::EpiBf16 E{slab + (size_t)sl * MCTX * D + (size_t)(pm * 256) * D + pn * 256, D, 0, 0};
        pg8::gemm_phase<pg8::EpiBf16, pg8::OneUnit, false, true>(lds, g, pg8::OneUnit{}, E);
    }
}


struct DstPlain { bf16_t* C; int ldc; DI bf16_t* at(int row, int col) const { return C + (size_t)row * ldc + col; } };
struct DstKV { bf16_t *Kc, *Vc; DI bf16_t* at(int row, int col) const { return col < 256 ? Kc + (size_t)row * 256 + col : Vc + (size_t)row * 256 + (col - 256); } };
template <int WM, int WN, int KS, int NW, class Dst>
DI void small_gemm(const bf16_t* __restrict__ A, const bf16_t* __restrict__ Bt, int M, int N, LAS unsigned char* lds, int vcu, int G, const Dst& dst) {
    constexpr int TR = 32 * WM, TC = 32 * WN * NW, CPR = KS / 8, RSTR = KS * 2 + 16, RPS = NTHREADS / CPR, NL = (TR + TC) / RPS, NS = D / KS;
    static_assert(WM * WN == NWAVES && TR % RPS == 0 && TC % RPS == 0 && (TR + TC) * RSTR <= LDS_BYTES - 64, "small_gemm shape");
    const int tid = tid_fresh(), w = tid >> 6, lane = tid & 63, l31 = lane & 31, hi = lane >> 5, wm = w % WM, wn = w / WM;
    const int nct = N / TC, njobs = (M / TR) * nct;
    const int lrow = tid / CPR, lch = tid % CPR;
    LAS unsigned char* wr = lds + lrow * RSTR + lch * 16;
    const LAS unsigned char* fa = lds + (32 * wm + l31) * RSTR + hi * 16;
    const LAS unsigned char* fb = lds + (TR + 32 * NW * wn + l31) * RSTR + hi * 16;
    __syncthreads();
    for (int j = vcu; j < njobs; j += G) {
        const int r0 = (j / nct) * TR, c0 = (j % nct) * TC;
        const bf16_t* pa = A + (size_t)(r0 + lrow) * D + lch * 8;
        const bf16_t* pb = Bt + (size_t)(c0 + lrow) * D + lch * 8;
        u32x4 pre[2][NL];
#pragma unroll
        for (int p = 0; p < 2; ++p)
#pragma unroll
            for (int i = 0; i < NL; ++i) pre[p][i] = *(const u32x4*)((RPS * i < TR ? pa + (size_t)(RPS * i) * D : pb + (size_t)(RPS * i - TR) * D) + p * KS);
        f32x16 acc[NW];
#pragma unroll
        for (int n = 0; n < NW; ++n)
#pragma unroll
            for (int i = 0; i < 16; ++i) acc[n][i] = 0.f;
#pragma unroll
        for (int st = 0; st < NS; ++st) {
#pragma unroll
            for (int i = 0; i < NL; ++i) *(LAS u32x4*)(wr + RPS * i * RSTR) = pre[st & 1][i];
            __syncthreads();
            if (st + 2 < NS) {
#pragma unroll
                for (int i = 0; i < NL; ++i) pre[st & 1][i] = *(const u32x4*)((RPS * i < TR ? pa + (size_t)(RPS * i) * D : pb + (size_t)(RPS * i - TR) * D) + (st + 2) * KS);
            }
#pragma unroll
            for (int s0 = 0; s0 < KS / 16; s0 += 8 / NW) {
                bf16x8 af[8 / NW], bf[8 / NW][NW];
#pragma unroll
                for (int s = 0; s < 8 / NW; ++s) { af[s] = *(const LAS bf16x8*)(fa + (s0 + s) * 32);
#pragma unroll
                    for (int n = 0; n < NW; ++n) bf[s][n] = *(const LAS bf16x8*)(fb + n * 32 * RSTR + (s0 + s) * 32); }
#pragma unroll
                for (int s = 0; s < 8 / NW; ++s)
#pragma unroll
                    for (int n = 0; n < NW; ++n) acc[n] = __builtin_amdgcn_mfma_f32_32x32x16_bf16(af[s], bf[s][n], acc[n], 0, 0, 0);
            }
            __syncthreads();
        }
        const size_t ldc = (size_t)(dst.at(1, 0) - dst.at(0, 0));
#pragma unroll
        for (int n = 0; n < NW; ++n) { bf16_t* cp = dst.at(r0 + 32 * wm + 4 * hi, c0 + 32 * (NW * wn + n) + l31);
#pragma unroll
            for (int i = 0; i < 16; ++i) cp[(size_t)((i & 3) + 8 * (i >> 2)) * ldc] = (bf16_t)f2bf(acc[n][i]); }
    }
}

__global__ void __launch_bounds__(NTHREADS, 2) mega_fwd(Args a) {
    extern __shared__ __attribute__((aligned(16))) unsigned char lds_raw[];
    LAS unsigned char* lds = (LAS unsigned char*)lds_raw;
    const int G = gridDim.x; const int bx = blockIdx.x; const int vcu = (G % 8 == 0) ? (bx % 8) * (G / 8) + bx / 8 : bx;
    unsigned char* ws = a.ws; float* out = a.out;
    float* mods = (float*)(ws + WS_MODS); float* xctx = (float*)(ws + WS_XCTX);
    bf16_t* U = (bf16_t*)(ws + WS_U); bf16_t* F = (bf16_t*)(ws + WS_F); bf16_t* Y = (bf16_t*)(ws + WS_Y); bf16_t* H = (bf16_t*)(ws + WS_H);
    bf16_t* Of = (bf16_t*)a.out; bf16_t* Ob = U; bf16_t* XB = (bf16_t*)(ws + WS_XB);
    const float* ng = a.norm_g;
    volatile LAS unsigned* MISC = (volatile LAS unsigned*)(lds + LDS_BYTES - 64);
    if (threadIdx.x == 0) { MISC[0] = 0u; MISC[1] = 0u; }
    __syncthreads();
    XcdBarrier xb = xcd_barrier_post((unsigned*)(ws + WS_BAR), MISC);

    phase_convert(a, lds, vcu, G); __syncthreads(); phase_adaln(a, lds, vcu, G); __syncthreads();
    GRID_SYNC();
    { RowArgs r{}; r.xold_lat = a.x; r.xold_ctx = a.ctx; r.u = U; r.gU = ng + 0 * D; r.modsU = mods; r.sidx = 0; r.nrows = MALL; phase_rows(r, vcu, G); }
    GRID_SYNC();
    run_gemm(lds, U, (const bf16_t*)(ws + WS_WRI), MALL, F_LR, D, pg8::EpiRecIn{F, NF, 0, (const float*)(ws + WS_LB), a.rec_b_g2}, G);
    small_gemm<8, 1, 128, 1>(U, (const bf16_t*)(ws + WS_WRI) + (size_t)F_LR * D, MALL, 32, lds, vcu, G, DstPlain{F + F_LR, NF});
    GRID_SYNC();
    for (int task = bx; task < 256; task += G) {
        const int id = task >> 1, dir = id & 1, hh = (id >> 1) & 3, b = id >> 3;
        if (task & 1) scan_mfma_task<64>(b, hh, dir, F, dir ? Ob : Of, a.rec_w_g2, a.rec_b_g2, lds);
        else scan_mfma_task<128>(b, hh, dir, F, dir ? Ob : Of, a.rec_w_g2, a.rec_b_g2, lds);
        __syncthreads();
    }
    GRID_SYNC();
    phase_combine(Of, Ob, F, a.gn_a, a.gn_b, Ob, vcu, G);
    GRID_SYNC();
    run_gemm(lds, Ob, (const bf16_t*)(ws + WS_WRO), MLAT, D, D, pg8::EpiBf16{Y, D, 0, 0}, G);
    small_gemm<4, 2, 128, 2>(Ob + (size_t)MLAT * D, (const bf16_t*)(ws + WS_WRO), MCTX, D, lds, vcu, G, DstPlain{Y + (size_t)MLAT * D, D});
    GRID_SYNC();
    { RowArgs r{}; r.xold_lat = a.x; r.xold_ctx = a.ctx; r.xnew_b = XB; r.y = Y; r.u = U; r.gY = ng + 1 * D; r.gU = ng + 2 * D; r.mods = mods; r.modsU = mods; r.gidx = 2; r.sidx = 3; r.nrows = MALL; phase_rows(r, vcu, G); }
    GRID_SYNC();
    run_gemm(lds, U, (const bf16_t*)(ws + WS_WFI0), MALL, 2 * FFH, D, pg8::EpiSwiglu{H, FFH, 0}, G);
    GRID_SYNC();
    run_gemm(lds, H, (const bf16_t*)(ws + WS_WFO0), MLAT, D, FFH, pg8::EpiBf16{Y, D, 0, 0}, G);
    run_gemm_ctx_splitk(lds, H + (size_t)MLAT * FFH, (const bf16_t*)(ws + WS_WFO0), FFH, (bf16_t*)a.out, G);
    GRID_SYNC();
    { RowArgs r{}; r.xold_b = XB; r.xnew_b = XB; r.y = Y; r.yslab = (const bf16_t*)a.out; r.u = U; r.gY = ng + 3 * D; r.gU = ng + 4 * D; r.mods = mods; r.modsU = mods + 17 * 6144; r.gidx = 5; r.sidx = 0; r.nrows = MALL; phase_rows(r, vcu, G); }
    GRID_SYNC();
    bf16_t* Qb = (bf16_t*)(ws + WS_Q); bf16_t* Kb = (bf16_t*)(ws + WS_K); bf16_t* Vb = (bf16_t*)(ws + WS_V); bf16_t* Kc = (bf16_t*)(ws + WS_KC); bf16_t* Vc = (bf16_t*)(ws + WS_VC); bf16_t* Oa = (bf16_t*)(ws + WS_O);
    run_gemm(lds, U, (const bf16_t*)(ws + WS_WQKV), MLAT, 1536, D, pg8::EpiQKV{Qb, Kb, Vb, (const float*)(ws + WS_ROPE)}, G);
    SG_REP small_gemm<4, 2, 256, 1>(U + (size_t)MLAT * D, (const bf16_t*)(ws + WS_WQKV) + (size_t)1024 * D, MCTX, 512, lds, vcu, G, DstKV{Kc, Vc});
    GRID_SYNC();
    attn_phase(Qb, Kb, Vb, Kc, Vc, a.att_sink, Oa, lds, vcu, G);
    GRID_SYNC();
    run_gemm(lds, Oa, (const bf16_t*)(ws + WS_WO), MLAT, D, D, pg8::EpiBf16{Y, D, 0, 0}, G);
    GRID_SYNC();
    { RowArgs r{}; r.xold_b = XB; r.xnew_b = XB; r.y = Y; r.u = U; r.gY = ng + 5 * D; r.gU = ng + 6 * D; r.mods = mods + 17 * 6144; r.modsU = mods + 17 * 6144; r.gidx = 2; r.sidx = 3; r.nrows = MLAT; phase_rows(r, vcu, G); }
    GRID_SYNC();
    run_gemm(lds, U, (const bf16_t*)(ws + WS_WFI1), MLAT, 2 * FFH, D, pg8::EpiSwiglu{H, FFH, 0}, G);
    GRID_SYNC();
    run_gemm(lds, H, (const bf16_t*)(ws + WS_WFO1), MLAT, D, FFH, pg8::EpiBf16{Y, D, 0, 0}, G);
    GRID_SYNC();
    { RowArgs r{}; r.xold_b = XB; r.xnew_lat = out; r.y = Y; r.gY = ng + 7 * D; r.mods = mods + 17 * 6144; r.gidx = 5; r.nrows = MLAT; phase_rows(r, vcu, G); }
}

extern "C" void kernel_launch(void* const* d_in, const int* in_sizes, int n_in, void* d_out, int out_size, void* d_ws, size_t ws_size, hipStream_t stream) {
    static int grid = 0;
    if (grid == 0) {
        if (n_in != 19 || out_size != MLAT * D || ws_size < WS_END) { fprintf(stderr, "kernel_launch: unexpected sizes n_in %d out %d ws %zu\n", n_in, out_size, ws_size); grid = -1; return; }
        int dev = 0, cus = 0, per_cu = 0;
        hipGetDevice(&dev); hipDeviceGetAttribute(&cus, hipDeviceAttributeMultiprocessorCount, dev);
        if (hipFuncSetAttribute((const void*)mega_fwd, hipFuncAttributeMaxDynamicSharedMemorySize, LDS_BYTES) != hipSuccess) { fprintf(stderr, "kernel_launch: hipFuncSetAttribute failed\n"); grid = -1; return; }
        if (hipOccupancyMaxActiveBlocksPerMultiprocessor(&per_cu, (const void*)mega_fwd, NTHREADS, LDS_BYTES) != hipSuccess || per_cu < 1) { fprintf(stderr, "kernel_launch: occupancy query says %d blocks per CU\n", per_cu); grid = -1; return; }
        grid = cus;
        fprintf(stderr, "kernel_launch: %d CUs, occupancy %d per CU, grid %d\n", cus, per_cu, grid);
    }
    if (grid < 0) return;
    Args a{};
    a.x = (const float*)d_in[0]; a.c = (const float*)d_in[1]; a.ctx = (const float*)d_in[2]; a.c_ctx = (const float*)d_in[3]; a.ada_w = (const float*)d_in[4]; a.ada_b = (const float*)d_in[5];
    a.norm_g = (const float*)d_in[6]; a.rec_w_in = (const float*)d_in[7]; a.rec_w_out = (const float*)d_in[8]; a.rec_lb = (const float*)d_in[9]; a.rec_w_g2 = (const float*)d_in[10];
    a.rec_b_g2 = (const float*)d_in[11]; a.gn_a = (const float*)d_in[12]; a.gn_b = (const float*)d_in[13]; a.att_w_qkv = (const float*)d_in[14]; a.att_w_o = (const float*)d_in[15];
    a.att_sink = (const float*)d_in[16]; a.ffn_w_in = (const float*)d_in[17]; a.ffn_w_out = (const float*)d_in[18];
    a.out = (float*)d_out; a.ws = (unsigned char*)d_ws;
    if (hipMemsetAsync((char*)d_ws + WS_BAR, 0, WS_BAR_BYTES, stream) != hipSuccess) { fprintf(stderr, "kernel_launch: memset failed\n"); return; }
    void* args[] = {&a};
    hipError_t e = hipLaunchCooperativeKernel((const void*)mega_fwd, dim3(grid), dim3(NTHREADS), args, LDS_BYTES, stream);
    if (e != hipSuccess) fprintf(stderr, "kernel_launch: cooperative launch failed: %s (grid %d)\n", hipGetErrorString(e), grid);
}
```

```cpp
#include <hip/hip_runtime.h>
#include <cstdint>
#include <cstdio>

namespace pg8 {
#define PG8_LAS __attribute__((address_space(3)))
typedef unsigned short bf16_t;
typedef short bf16x8 __attribute__((ext_vector_type(8)));
typedef float f32x4 __attribute__((ext_vector_type(4)));
typedef unsigned u32x4 __attribute__((ext_vector_type(4)));
constexpr int BM = 256, BK = 64, HALF = 128, HTB = HALF * BK * 2  , STAGE_BYTES = 8 * HTB, NXCD = 8, WGM = 4;

__host__ __device__ __forceinline__ int lds_byte(int r, int c) { const int st = (r >> 4) * 2 + (c >> 5), rr = r & 15, cc = c & 31, ob = rr * 64 + cc * 2; return st * 1024 + (ob ^ (((ob >> 9) & 1) << 5)); }
__host__ __device__ __forceinline__ void stage_rc(int b, int& R, int& C) { const int st = b / 1024, sb = b % 1024, swz = sb ^ (((sb >> 9) & 1) << 5); R = (st >> 1) * 16 + swz / 64; C = (st & 1) * 32 + (swz % 64) / 2; }
__host__ __device__ __forceinline__ int perm32(int rho) { const int n = rho >> 4, i = rho & 15; return 8 * (i >> 2) + 4 * n + (i & 3); }

struct Unit { int pm, pn; };
struct Gemm { const bf16_t* A; const bf16_t* Bt; int M, N, K, ld; };

struct StaticOrder {
    int nM, nN, nwg, G, c, wgm;
    __host__ __device__ void init(int M, int N, int G_, int c_, int wgm_ = WGM) { nM = M / BM; nN = N / BM; nwg = nM * nN; G = G_; c = c_; wgm = wgm_; }
    __host__ __device__ bool next(int i, Unit& u) const {
        const long L = (long)i * G + c; if (L >= nwg) return false;
        int wgid = (int)L; { const int q = nwg / NXCD, r = nwg % NXCD, xcd = wgid % NXCD, off = wgid / NXCD; wgid = (xcd < r ? xcd * (q + 1) : r * (q + 1) + (xcd - r) * q) + off; }
        const int nig = wgm * nN, gid = wgid / nig, fm = gid * wgm, gsz = (nM - fm) < wgm ? (nM - fm) : wgm;
        u.pm = fm + ((wgid % nig) % gsz); u.pn = (wgid % nig) / gsz; return true;
    }
    __device__ __forceinline__ void a_ready(const Unit&) const {}
    __device__ __forceinline__ void done(const Unit&) const {}
};


__device__ __forceinline__ unsigned cvt_pk_bf16(float lo, float hi) { unsigned r; asm volatile("v_cvt_pk_bf16_f32 %0, %1, %2" : "=v"(r) : "v"(lo), "v"(hi)); return r; }
typedef float f32x2 __attribute__((ext_vector_type(2)));

struct EpiBf16 {
    static constexpr bool PERM = true, AFTER_DRAIN = false;
    bf16_t* O; int ldc; int split_cols; size_t split_stride;
    __device__ __forceinline__ void operator()(const f32x4 (&acc)[2][2][4][2], const Unit& u, int wr, int wc, int fr, int fq) const {
        const int row0 = u.pm * BM + wr * 64 + fr; int colt = u.pn * BM; bf16_t* base = O;
        if (split_cols) { const int t = colt / split_cols; base += (size_t)t * split_stride; colt -= t * split_cols; }
        const int col0 = colt + wc * 32 + 8 * fq;
#pragma unroll
        for (int ai = 0; ai < 2; ++ai)
#pragma unroll
            for (int m = 0; m < 4; ++m) { bf16_t* rowp = base + (size_t)(row0 + ai * HALF + m * 16) * ldc + col0;
#pragma unroll
                for (int bj = 0; bj < 2; ++bj) { const f32x4 v0 = acc[ai][bj][m][0], v1 = acc[ai][bj][m][1];
                    u32x4 w; w.x = cvt_pk_bf16(v0[0], v0[1]); w.y = cvt_pk_bf16(v0[2], v0[3]); w.z = cvt_pk_bf16(v1[0], v1[1]); w.w = cvt_pk_bf16(v1[2], v1[3]);
                    *(u32x4*)(rowp + bj * HALF) = w; } }
    }
};
__device__ __forceinline__ float silu_fast(float x) { return x * __builtin_amdgcn_rcpf(1.f + __builtin_amdgcn_exp2f(-1.4426950408889634f * x)); }
struct EpiSwiglu {
    static constexpr bool PERM = true, AFTER_DRAIN = false;
    bf16_t* H; int ldh; int pad;
    __device__ __forceinline__ void operator()(const f32x4 (&acc)[2][2][4][2], const Unit& u, int wr, int wc, int fr, int fq) const {
        const int row0 = u.pm * BM + wr * 64 + fr; const int col0 = u.pn * HALF + wc * 32 + 8 * fq;
#pragma unroll
        for (int ai = 0; ai < 2; ++ai)
#pragma unroll
            for (int m = 0; m < 4; ++m) { bf16_t* rowp = H + (size_t)(row0 + ai * HALF + m * 16) * ldh + col0;
                float o[8];
#pragma unroll
                for (int n = 0; n < 2; ++n)
#pragma unroll
                    for (int j = 0; j < 4; ++j) { const float g2 = acc[ai][0][m][n][j]; o[4 * n + j] = (g2 * __builtin_amdgcn_rcpf(1.f + __builtin_amdgcn_exp2f(-g2))) * acc[ai][1][m][n][j]; }
                u32x4 w; w.x = cvt_pk_bf16(o[0], o[1]); w.y = cvt_pk_bf16(o[2], o[3]); w.z = cvt_pk_bf16(o[4], o[5]); w.w = cvt_pk_bf16(o[6], o[7]);
                *(u32x4*)rowp = w; }
    }
};
struct OneUnit { __host__ __device__ bool next(int i, Unit& u) const { if (i > 0) return false; u.pm = 0; u.pn = 0; return true; }
    __device__ __forceinline__ void a_ready(const Unit&) const {} __device__ __forceinline__ void done(const Unit&) const {} };
struct EpiRecIn {
    static constexpr bool PERM = true, AFTER_DRAIN = false;
    bf16_t* O; int ldc; int pad; const float* lb; const float* bg;
    __device__ __forceinline__ void operator()(const f32x4 (&acc)[2][2][4][2], const Unit& u, int wr, int wc, int fr, int fq) const {
        const int row0 = u.pm * BM + wr * 64 + fr; const int colt = u.pn * BM; const int col0 = colt + wc * 32 + 8 * fq;
        const int mode = u.pn < 2 ? 1 : (u.pn < 6 ? 2 : 0);
        float cst[2][8];
#pragma unroll
        for (int bj = 0; bj < 2; ++bj)
#pragma unroll
            for (int j = 0; j < 8; ++j) cst[bj][j] = 0.f;
        if (mode == 2) {
#pragma unroll
            for (int bj = 0; bj < 2; ++bj) { const f32x4 a = *(const f32x4*)(lb + col0 + bj * HALF - 512), b = *(const f32x4*)(lb + col0 + bj * HALF - 512 + 4);
                cst[bj][0] = 1.f - a[0]; cst[bj][1] = 1.f - a[1]; cst[bj][2] = 1.f - a[2]; cst[bj][3] = 1.f - a[3]; cst[bj][4] = 1.f - b[0]; cst[bj][5] = 1.f - b[1]; cst[bj][6] = 1.f - b[2]; cst[bj][7] = 1.f - b[3]; } }
        else if (mode == 3) {
#pragma unroll
            for (int bj = 0; bj < 2; ++bj) { const f32x4 a = *(const f32x4*)(bg + col0 + bj * HALF - 3584), b = *(const f32x4*)(bg + col0 + bj * HALF - 3584 + 4);
                cst[bj][0] = a[0]; cst[bj][1] = a[1]; cst[bj][2] = a[2]; cst[bj][3] = a[3]; cst[bj][4] = b[0]; cst[bj][5] = b[1]; cst[bj][6] = b[2]; cst[bj][7] = b[3]; } }
#pragma unroll
        for (int ai = 0; ai < 2; ++ai)
#pragma unroll
            for (int m = 0; m < 4; ++m) { bf16_t* rowp = O + (size_t)(row0 + ai * HALF + m * 16) * ldc + col0;
#pragma unroll
                for (int bj = 0; bj < 2; ++bj) { float v[8];
#pragma unroll
                    for (int j = 0; j < 4; ++j) { v[j] = acc[ai][bj][m][0][j]; v[4 + j] = acc[ai][bj][m][1][j]; }
                    if (mode == 1) {
#pragma unroll
                        for (int j = 0; j < 8; ++j) v[j] = silu_fast(v[j]) * 0.08838834764831845f; }
                    else if (mode == 2) {
#pragma unroll
                        for (int j = 0; j < 8; ++j) v[j] = cst[bj][j] * __builtin_amdgcn_rcpf(1.f + __builtin_amdgcn_exp2f(1.4426950408889634f * v[j])); }
                    else if (mode == 3) {
#pragma unroll
                        for (int j = 0; j < 8; ++j) { const float x = v[j] + cst[bj][j]; const float e = __builtin_amdgcn_exp2f(-1.4426950408889634f * __builtin_fabsf(x));
                            v[j] = (__builtin_fminf(x, 0.f) * 1.4426950408889634f - __builtin_amdgcn_logf(1.f + e)) * (1.f / 16.f); } }
                    u32x4 w; w.x = cvt_pk_bf16(v[0], v[1]); w.y = cvt_pk_bf16(v[2], v[3]); w.z = cvt_pk_bf16(v[4], v[5]); w.w = cvt_pk_bf16(v[6], v[7]);
                    *(u32x4*)(rowp + bj * HALF) = w; } }
    }
};
struct EpiQKV {
    static constexpr bool PERM = true, AFTER_DRAIN = false;
    bf16_t *Q, *Kd, *V; const float* rope;
    __device__ __forceinline__ void operator()(const f32x4 (&acc)[2][2][4][2], const Unit& u, int wr, int wc, int fr, int fq) const {
        const int row0 = u.pm * BM + wr * 64 + fr; const int i0 = (wc & 1) * 16 + 4 * fq;
#pragma unroll
        for (int ai = 0; ai < 2; ++ai)
#pragma unroll
            for (int m = 0; m < 4; ++m) { const int r = row0 + ai * HALF + m * 16; const int t = r & 2047;
                f32x4 cs = (f32x4){1.f, 1.f, 1.f, 1.f}, sn = (f32x4){0.f, 0.f, 0.f, 0.f};
                if (u.pn < 5) { cs = *(const f32x4*)(rope + t * 32 + i0); sn = *(const f32x4*)(rope + 2048 * 32 + t * 32 + i0); }
#pragma unroll
                for (int bj = 0; bj < 2; ++bj) { const f32x4 v0 = acc[ai][bj][m][0], v1 = acc[ai][bj][m][1]; const int c = u.pn * BM + bj * HALF + wc * 32 + 8 * fq;
                    float o[8];
                    o[0] = v0[0] * cs[0] - v0[1] * sn[0]; o[1] = v0[0] * sn[0] + v0[1] * cs[0]; o[2] = v0[2] * cs[1] - v0[3] * sn[1]; o[3] = v0[2] * sn[1] + v0[3] * cs[1];
                    o[4] = v1[0] * cs[2] - v1[1] * sn[2]; o[5] = v1[0] * sn[2] + v1[1] * cs[2]; o[6] = v1[2] * cs[3] - v1[3] * sn[3]; o[7] = v1[2] * sn[3] + v1[3] * cs[3];
                    const float sc = u.pn < 4 ? 0.125f * 1.4426950408889634f : 1.f;
                    u32x4 w; w.x = cvt_pk_bf16(o[0] * sc, o[1] * sc); w.y = cvt_pk_bf16(o[2] * sc, o[3] * sc); w.z = cvt_pk_bf16(o[4] * sc, o[5] * sc); w.w = cvt_pk_bf16(o[6] * sc, o[7] * sc);
                    bf16_t* dst = u.pn < 4 ? Q + (size_t)r * 1024 + c : (u.pn == 4 ? Kd + (size_t)r * 256 + (c - 1024) : V + (size_t)r * 256 + (c - 1280));
                    *(u32x4*)dst = w; } }
    }
};
template <class Epi, class Sched, bool ALIGN_EPI = false, bool SP2 = false>
__device__ __forceinline__ void gemm_phase(PG8_LAS unsigned char* lds, const Gemm g, const Sched& S, const Epi& E) {
    int tid = threadIdx.x; asm volatile("" : "+v"(tid)); const int wid = __builtin_amdgcn_readfirstlane(tid >> 6), lane = tid & 63, wr = wid >> 2, wc = wid & 3, fr = lane & 15, fq = lane >> 4;
    const int K = g.ld, nt = g.K / BK;
    unsigned voffA[2], voffB[2];
#pragma unroll
    for (int i = 0; i < 2; ++i) { int R, C; stage_rc(tid * 16 + i * 8192, R, C); const int Rb = Epi::PERM ? ((R & ~31) + perm32(R & 31)) : R;
        voffA[i] = (unsigned)(R * K + C) * 2u; voffB[i] = (unsigned)(Rb * K + C) * 2u; }
    const size_t kstep = (size_t)(BK * 2);
    const size_t hstep = (size_t)HALF * K * 2;
    const size_t tstep = 2 * hstep;
    const unsigned ldsw = (unsigned)wid * 1024u;
    const int aoff = lds_byte(wr * 64 + fr, fq * 8), boff = lds_byte(wc * 32 + fr, fq * 8);
#define PG8_SA(b, h) (((b) * 2 + (h)) * HTB)
#define PG8_SB(b, h) ((4 + (b) * 2 + (h)) * HTB)
#define PG8_STAGE(bufoff, gbase, voff) do { _Pragma("unroll") for (int _i = 0; _i < 2; ++_i) \
        __builtin_amdgcn_global_load_lds((const unsigned*)((const char*)(gbase) + (voff)[_i]), (PG8_LAS unsigned*)(lds + (bufoff) + ldsw + _i * 8192), 16, 0, 0); } while (0)
#define PG8_LDA(dst, b, h) do { _Pragma("unroll") for (int m = 0; m < 4; ++m) _Pragma("unroll") for (int k = 0; k < 2; ++k) dst[m][k] = *(const PG8_LAS bf16x8*)(lds + PG8_SA(b, h) + aoff + m * 2048 + k * 1024); } while (0)
#define PG8_LDB(dst, b, h) do { _Pragma("unroll") for (int n = 0; n < 2; ++n) _Pragma("unroll") for (int k = 0; k < 2; ++k) dst[n][k] = *(const PG8_LAS bf16x8*)(lds + PG8_SB(b, h) + boff + n * 2048 + k * 1024); } while (0)
#define PG8_MMA(ai, bj, At, Bt) do { __builtin_amdgcn_s_setprio(1); _Pragma("unroll") for (int m = 0; m < 4; ++m) _Pragma("unroll") for (int n = 0; n < 2; ++n) _Pragma("unroll") for (int k = 0; k < 2; ++k) \
        acc[ai][bj][m][n] = __builtin_amdgcn_mfma_f32_16x16x32_bf16(Bt[n][k], At[m][k], acc[ai][bj][m][n], 0, 0, 0); __builtin_amdgcn_s_setprio(0); } while (0)
#define PG8_WAIT_V(n) asm volatile("s_waitcnt vmcnt(" #n ")" ::: "memory")
#define PG8_WAIT_L(n) asm volatile("s_waitcnt lgkmcnt(" #n ")" ::: "memory")
#define PG8_BAR __builtin_amdgcn_s_barrier()
#define PG8_SCHED __builtin_amdgcn_sched_barrier(0)
    Unit cur, nxt; int ui = 0;
    if (!S.next(0, cur)) return;
    f32x4 acc[2][2][4][2];
#pragma unroll
    for (int a = 0; a < 2; ++a)
#pragma unroll
        for (int b = 0; b < 2; ++b)
#pragma unroll
            for (int m = 0; m < 4; ++m)
#pragma unroll
                for (int n = 0; n < 2; ++n) acc[a][b][m][n] = (f32x4){0.f, 0.f, 0.f, 0.f};
    bf16x8 At[4][2], B0[2][2], B1[2][2];
    const char* cA = (const char*)g.A + (size_t)cur.pm * tstep; const char* cB = (const char*)g.Bt + (size_t)cur.pn * tstep;
    S.a_ready(cur);
    if constexpr (SP2) {
        PG8_STAGE(PG8_SB(0, 0), cB, voffB); PG8_STAGE(PG8_SB(0, 1), cB + hstep, voffB); PG8_STAGE(PG8_SA(0, 0), cA, voffA); PG8_STAGE(PG8_SA(0, 1), cA + hstep, voffA);
        if (wr == 1) PG8_BAR;
        PG8_WAIT_V(2); PG8_BAR;
        PG8_STAGE(PG8_SB(1, 0), cB + kstep, voffB); PG8_STAGE(PG8_SA(1, 0), cA + kstep, voffA); PG8_STAGE(PG8_SB(1, 1), cB + hstep + kstep, voffB);
        PG8_WAIT_V(6); PG8_BAR;
    } else {
        PG8_STAGE(PG8_SB(0, 0), cB, voffB); PG8_STAGE(PG8_SA(0, 0), cA, voffA); PG8_STAGE(PG8_SB(0, 1), cB + hstep, voffB); PG8_STAGE(PG8_SA(0, 1), cA + hstep, voffA);
        if (wr == 1) PG8_BAR;
        PG8_WAIT_V(4); PG8_BAR;
        PG8_STAGE(PG8_SB(1, 0), cB + kstep, voffB); PG8_STAGE(PG8_SA(1, 0), cA + kstep, voffA); PG8_STAGE(PG8_SB(1, 1), cB + hstep + kstep, voffB);
        PG8_WAIT_V(6); PG8_BAR;
    }
    for (;;) {
        const bool has_next = S.next(ui + 1, nxt);
        const char* nA = has_next ? (const char*)g.A + (size_t)nxt.pm * tstep : cA; const char* nB = has_next ? (const char*)g.Bt + (size_t)nxt.pn * tstep : cB;
        for (int t = 0; t < nt; t += 2) {
            const bool last = (t == nt - 2);
            const char* a1 = cA + (size_t)(t + 1) * kstep;
            const char* a2 = last ? nA : cA + (size_t)(t + 2) * kstep; const char* b2 = last ? nB : cB + (size_t)(t + 2) * kstep;
            const char* a3 = a2 + kstep; const char* b3 = b2 + kstep;
            if (last && has_next) S.a_ready(nxt);
            if constexpr (SP2) {
            PG8_LDB(B0, 0, 0); PG8_LDB(B1, 0, 1); PG8_SCHED; PG8_LDA(At, 0, 0); PG8_STAGE(PG8_SA(1, 1), a1 + hstep, voffA);
            PG8_WAIT_V(8); PG8_WAIT_L(0); PG8_BAR; PG8_MMA(0, 0, At, B0); PG8_MMA(0, 1, At, B1); PG8_BAR; PG8_SCHED;
            PG8_LDA(At, 0, 1); PG8_STAGE(PG8_SB(0, 0), b2, voffB); PG8_STAGE(PG8_SB(0, 1), b2 + hstep, voffB); PG8_STAGE(PG8_SA(0, 0), a2, voffA);
            PG8_WAIT_V(8); PG8_WAIT_L(0); PG8_BAR; PG8_MMA(1, 0, At, B0); PG8_MMA(1, 1, At, B1); PG8_BAR; PG8_SCHED;
            PG8_LDB(B0, 1, 0); PG8_LDB(B1, 1, 1); PG8_SCHED; PG8_LDA(At, 1, 0); PG8_STAGE(PG8_SA(0, 1), a2 + hstep, voffA);
            PG8_WAIT_V(8); PG8_WAIT_L(0); PG8_BAR; PG8_MMA(0, 0, At, B0); PG8_MMA(0, 1, At, B1); PG8_BAR; PG8_SCHED;
            PG8_LDA(At, 1, 1); PG8_STAGE(PG8_SB(1, 0), b3, voffB); PG8_STAGE(PG8_SB(1, 1), b3 + hstep, voffB); PG8_STAGE(PG8_SA(1, 0), a3, voffA);
            PG8_WAIT_V(8); PG8_WAIT_L(0); PG8_BAR; PG8_MMA(1, 0, At, B0); PG8_MMA(1, 1, At, B1); PG8_BAR; PG8_SCHED;
            } else {
            PG8_LDB(B0, 0, 0); PG8_SCHED; PG8_LDA(At, 0, 0); PG8_STAGE(PG8_SA(1, 1), a1 + hstep, voffA);
            PG8_WAIT_L(8); PG8_BAR; PG8_WAIT_L(0); PG8_MMA(0, 0, At, B0); PG8_BAR; PG8_SCHED;
            PG8_LDB(B1, 0, 1); PG8_STAGE(PG8_SB(0, 0), b2, voffB);
            PG8_BAR; PG8_WAIT_L(0); PG8_MMA(0, 1, At, B1); PG8_BAR;
            PG8_LDA(At, 0, 1); PG8_STAGE(PG8_SA(0, 0), a2, voffA);
            PG8_BAR; PG8_WAIT_L(0); PG8_MMA(1, 0, At, B0); PG8_BAR; PG8_SCHED;
            PG8_STAGE(PG8_SB(0, 1), b2 + hstep, voffB);
            PG8_WAIT_V(6); PG8_BAR; PG8_MMA(1, 1, At, B1); PG8_BAR;
            PG8_LDB(B0, 1, 0); PG8_SCHED; PG8_LDA(At, 1, 0); PG8_STAGE(PG8_SA(0, 1), a2 + hstep, voffA);
            PG8_WAIT_L(8); PG8_BAR; PG8_WAIT_L(0); PG8_MMA(0, 0, At, B0); PG8_BAR; PG8_SCHED;
            PG8_LDB(B1, 1, 1); PG8_STAGE(PG8_SB(1, 0), b3, voffB);
            PG8_BAR; PG8_WAIT_L(0); PG8_MMA(0, 1, At, B1); PG8_BAR;
            PG8_LDA(At, 1, 1); PG8_STAGE(PG8_SA(1, 0), a3, voffA);
            PG8_BAR; PG8_WAIT_L(0); PG8_MMA(1, 0, At, B0); PG8_BAR; PG8_SCHED;
            PG8_STAGE(PG8_SB(1, 1), b3 + hstep, voffB);
            PG8_WAIT_V(6); PG8_BAR; PG8_MMA(1, 1, At, B1); PG8_BAR;
            }
        }
        if constexpr (ALIGN_EPI) { if (wr == 0) PG8_BAR; }
        if constexpr (!Epi::AFTER_DRAIN) { E(acc, cur, wr, wc, fr, fq); S.done(cur); }
        if (!has_next) break;
#pragma unroll
        for (int a = 0; a < 2; ++a)
#pragma unroll
            for (int b = 0; b < 2; ++b)
#pragma unroll
                for (int m = 0; m < 4; ++m)
#pragma unroll
                    for (int n = 0; n < 2; ++n) acc[a][b][m][n] = (f32x4){0.f, 0.f, 0.f, 0.f};
        cur = nxt; cA = nA; cB = nB; ++ui;
        if constexpr (ALIGN_EPI) { if (wr == 1) PG8_BAR; }
    }
    PG8_WAIT_V(0);
    if constexpr (!ALIGN_EPI) { if (wr == 0) PG8_BAR; }
    PG8_BAR;
    if constexpr (Epi::AFTER_DRAIN) { E.fused(acc, cur, wr, wc, fr, fq, lds, wid, lane); S.done(cur); }
#undef PG8_SA
#undef PG8_SB
#undef PG8_STAGE
#undef PG8_LDA
#undef PG8_LDB
#undef PG8_MMA
#undef PG8_WAIT_V
#undef PG8_WAIT_L
#undef PG8_BAR
#undef PG8_SCHED
}
}


#define DI __device__ __forceinline__
DI int tid_fresh() { int t = threadIdx.x; asm volatile("" : "+v"(t)); return t; }
typedef unsigned short bf16_t;
typedef short bf16x8 __attribute__((ext_vector_type(8)));
typedef float f32x4 __attribute__((ext_vector_type(4)));
typedef unsigned u32x4 __attribute__((ext_vector_type(4)));
typedef unsigned u32x2 __attribute__((ext_vector_type(2)));
#define LAS __attribute__((address_space(3)))

constexpr int D = 1024, NB = 16, T = 2048, LC = 256;
constexpr int MLAT = NB * T, MCTX = NB * LC, MALL = MLAT + MCTX;
constexpr int NF = 4352;
constexpr int FFH = 2816;
constexpr float EPS = 1e-6f;
constexpr int F_AQ = 0, F_AZF = 512, F_AZB = 1024, F_AI = 1536, F_AOG = 2048, F_BQ = 2560, F_BK = 2816, F_BV = 3072, F_BR = 3584, F_LR = 4096;
constexpr int NTHREADS = 512, NWAVES = 8;
constexpr int LDS_BYTES = 147456;

constexpr size_t MiB = 1u << 20;
constexpr size_t WS_BAR = 0, WS_BAR_BYTES = 65536;
constexpr size_t WS_MODS = 1 * MiB;
constexpr size_t WS_ROPE = 2 * MiB;
constexpr size_t WS_LB = 3 * MiB;
constexpr size_t WS_WRI = 4 * MiB;
constexpr size_t WS_WRO = 13 * MiB;
constexpr size_t WS_WQKV = 15 * MiB;
constexpr size_t WS_WO = 18 * MiB;
constexpr size_t WS_WFI0 = 20 * MiB, WS_WFI1 = 31 * MiB;
constexpr size_t WS_WFO0 = 42 * MiB, WS_WFO1 = 48 * MiB;
constexpr size_t WS_XCTX = 56 * MiB;
constexpr size_t WS_U = 72 * MiB;
constexpr size_t WS_F = 144 * MiB;
constexpr size_t WS_Y = 144 * MiB;
constexpr size_t WS_H = 216 * MiB;
constexpr size_t WS_Q = 216 * MiB, WS_K = 280 * MiB, WS_V = 296 * MiB, WS_KC = 312 * MiB, WS_VC = 314 * MiB, WS_O = 316 * MiB;
constexpr size_t WS_XB = 414 * MiB;
constexpr size_t WS_END = 512 * MiB;

DI unsigned f2bf(float f) { unsigned u = __float_as_uint(f); return (u + 0x7fffu + ((u >> 16) & 1u)) >> 16; }
DI float bf2f(unsigned h) { return __uint_as_float(h << 16); }
DI unsigned pk2(float lo, float hi) { return f2bf(lo) | (f2bf(hi) << 16); }
DI float wave_sum(float v) {
#pragma unroll
    for (int o = 1; o < 64; o <<= 1) v += __shfl_xor(v, o);
    return v;
}
DI float sigmoid_f(float x) { return 1.f / (1.f + expf(-x)); }
DI float silu_f(float x) { return x / (1.f + expf(-x)); }
DI float logsigmoid_f(float z) { return fminf(z, 0.f) - log1pf(expf(-fabsf(z))); }

struct Args {
    const float *x, *c, *ctx, *c_ctx, *ada_w, *ada_b, *norm_g, *rec_w_in, *rec_w_out, *rec_lb, *rec_w_g2, *rec_b_g2, *gn_a, *gn_b, *att_w_qkv, *att_w_o, *att_sink, *ffn_w_in, *ffn_w_out;
    float* out; unsigned char* ws;
};

DI void transpose_item(const float* W, int ldw, int src_col0, bf16_t* WT, int K, int dst_row0, int k0, LAS float* scr, int lane, float scale = 1.f) {
#pragma unroll 16
    for (int kk = 0; kk < 64; ++kk) scr[kk * 65 + lane] = W[(size_t)(k0 + kk) * ldw + src_col0 + lane];
    asm volatile("s_waitcnt lgkmcnt(0)" ::: "memory");
    const int c = lane & 7;
#pragma unroll
    for (int j = 0; j < 8; ++j) { const int n = (lane >> 3) + 8 * j; const LAS float* s = scr + (8 * c) * 65 + n;
        u32x4 o; o.x = pk2(s[0 * 65] * scale, s[1 * 65] * scale); o.y = pk2(s[2 * 65] * scale, s[3 * 65] * scale); o.z = pk2(s[4 * 65] * scale, s[5 * 65] * scale); o.w = pk2(s[6 * 65] * scale, s[7 * 65] * scale);
        *(u32x4*)(WT + (size_t)(dst_row0 + n) * K + k0 + 8 * c) = o; }
    asm volatile("s_waitcnt lgkmcnt(0)" ::: "memory");
}
DI void phase_convert(const Args& a, LAS unsigned char* lds, int vcu, int G) {
    const int tidc = tid_fresh(); const int lane = tidc & 63, wid = tidc >> 6;
    LAS float* scr = (LAS float*)(lds + wid * 16640);
    const int gw = vcu * NWAVES + wid, NGW = G * NWAVES;
    constexpr int KB1 = D / 64, KB2 = FFH / 64;
    constexpr int I_RI = (4096 / 64) * KB1, I_RO = (D / 64) * KB1, I_QKV = (1536 / 64) * KB1, I_WO = (D / 64) * KB1, I_FI = (5632 / 64) * KB1, I_FO = (D / 64) * KB2;
    constexpr int NIT = I_RI + I_RO + I_QKV + I_WO + 2 * I_FI + 2 * I_FO;
    for (int it = gw; it < NIT; it += NGW) {
        int r = it;
        if (r < I_RI) { const int nb = r / KB1, kb = r % KB1; const int n0 = nb * 64;
            const int src = n0 < F_BR ? n0 : 3616 + (n0 - F_BR);
            transpose_item(a.rec_w_in, 4128, src, (bf16_t*)(a.ws + WS_WRI), D, n0, kb * 64, scr, lane); continue; }
        r -= I_RI;
        if (r < I_RO) { const int nb = r / KB1, kb = r % KB1; transpose_item(a.rec_w_out, D, nb * 64, (bf16_t*)(a.ws + WS_WRO), D, nb * 64, kb * 64, scr, lane); continue; }
        r -= I_RO;
        if (r < I_QKV) { const int nb = r / KB1, kb = r % KB1; transpose_item(a.att_w_qkv, 1536, nb * 64, (bf16_t*)(a.ws + WS_WQKV), D, nb * 64, kb * 64, scr, lane); continue; }
        r -= I_QKV;
        if (r < I_WO) { const int nb = r / KB1, kb = r % KB1; transpose_item(a.att_w_o, D, nb * 64, (bf16_t*)(a.ws + WS_WO), D, nb * 64, kb * 64, scr, lane); continue; }
        r -= I_WO;
        if (r < 2 * I_FI) { const int l = r / I_FI; r %= I_FI; const int nb = r / KB1, kb = r % KB1;
            const int p = nb >> 2, wq = nb & 3; const int src = wq < 2 ? p * 128 + 64 * wq : FFH + p * 128 + 64 * (wq - 2);
            transpose_item(a.ffn_w_in + (size_t)l * D * 5632, 5632, src, (bf16_t*)(a.ws + (l ? WS_WFI1 : WS_WFI0)), D, nb * 64, kb * 64, scr, lane, wq < 2 ? 1.4426950408889634f : 0.6931471805599453f); continue; }
        r -= 2 * I_FI;
        { const int l = r / I_FO; r %= I_FO; const int nb = r / KB2, kb = r % KB2;
            transpose_item(a.ffn_w_out + (size_t)l * FFH * D, D, nb * 64, (bf16_t*)(a.ws + (l ? WS_WFO1 : WS_WFO0)), FFH, nb * 64, kb * 64, scr, lane); }
    }
    const int gt = vcu * NTHREADS + tidc, NGT = G * NTHREADS;
    for (int it = gt; it < 256 * (D / 8); it += NGT) {
        const int k8 = it % (D / 8), n = it / (D / 8);
        u32x4 w4 = (u32x4){0u, 0u, 0u, 0u};
        if (n < 32) { float o[8];
#pragma unroll
            for (int kk = 0; kk < 8; ++kk) o[kk] = a.rec_w_in[(size_t)(k8 * 8 + kk) * 4128 + 3584 + n];
            w4.x = pk2(o[0], o[1]); w4.y = pk2(o[2], o[3]); w4.z = pk2(o[4], o[5]); w4.w = pk2(o[6], o[7]); }
        *(u32x4*)((bf16_t*)(a.ws + WS_WRI) + (size_t)(F_LR + n) * D + k8 * 8) = w4;
    }
    for (int it = gt; it < T * 32; it += NGT) { const int t = it >> 5, i = it & 31; const int row = t >> 6, col = t & 63;
        const float inv = powf(10000.f, -(float)(2 * (i & 15)) / 32.f); const float ang = (i < 16 ? (float)row : (float)col) * inv;
        float s, c; sincosf(ang, &s, &c); ((float*)(a.ws + WS_ROPE))[it] = c; ((float*)(a.ws + WS_ROPE))[T * 32 + it] = s; }
    for (int it = gt; it < 1024; it += NGT) { const float l0 = a.rec_lb[it], l1 = a.rec_lb[1024 + it]; ((float*)(a.ws + WS_LB))[it] = 1.f / (1.f + expf(l1 - l0)); }
}

DI void phase_adaln(const Args& a, LAS unsigned char* lds, int vcu, int G) {
    LAS float* sc = (LAS float*)lds;
    LAS float* red = (LAS float*)(lds + 17 * 1024 * 4);
    float* mods = (float*)(a.ws + WS_MODS);
    const int tida = tid_fresh(); const int lane = tida & 63, wid = tida >> 6, cx = tida & 15, kg = tida >> 4;
    for (int e = tida; e < 17 * 1024; e += NTHREADS) { const int s = e >> 10, k = e & 1023; const float cv = s < 16 ? a.c[s * D + k] : a.c_ctx[k]; sc[k * 17 + s] = silu_f(cv); }
    __syncthreads();
    for (int item = vcu; item < 256; item += G) {
        const int col0 = item * 48, l = col0 / 6144, j0 = col0 % 6144;
        float acc[3][17];
#pragma unroll
        for (int q = 0; q < 3; ++q)
#pragma unroll
            for (int s = 0; s < 17; ++s) acc[q][s] = 0.f;
        const float* w = a.ada_w + (size_t)l * D * 6144 + j0 + cx;
#pragma unroll 4
        for (int kk = 0; kk < 32; ++kk) { const int k = kg * 32 + kk; const float* wr = w + (size_t)k * 6144;
            const float w0 = wr[0], w1 = wr[16], w2 = wr[32];
#pragma unroll
            for (int s = 0; s < 17; ++s) { const float cv = sc[k * 17 + s]; acc[0][s] += cv * w0; acc[1][s] += cv * w1; acc[2][s] += cv * w2; } }
#pragma unroll
        for (int q = 0; q < 3; ++q)
#pragma unroll
            for (int s = 0; s < 17; ++s) { float v = acc[q][s]; v += __shfl_xor(v, 16); v += __shfl_xor(v, 32); if (lane < 16) red[(wid * 51 + q * 17 + s) * 16 + cx] = v; }
        __syncthreads();
        for (int e = tida; e < 51 * 16; e += NTHREADS) { const int qs = e >> 4, x = e & 15, q = qs / 17, s = qs % 17; float v = 0.f;
#pragma unroll
            for (int g = 0; g < 8; ++g) v += red[(g * 51 + qs) * 16 + x];
            const int j = j0 + q * 16 + x; mods[((size_t)l * 17 + s) * 6144 + j] = v + a.ada_b[l * 6144 + j]; }
        __syncthreads();
    }
}

struct RowArgs {
    const float* xold_lat; const float* xold_ctx;
    float* xnew_lat; float* xnew_ctx;
    const bf16_t* xold_b; bf16_t* xnew_b;
    const bf16_t* y;
    const bf16_t* yslab;
    bf16_t* u;
    const float* gY; const float* gU;
    const float* mods;
    const float* modsU;
    int gidx, sidx, nrows, pad;
};
typedef float f32x2r_t __attribute__((ext_vector_type(2))); typedef __bf16 bf16x2r_t __attribute__((ext_vector_type(2)));
DI unsigned cvtpk_r(float lo, float hi) { f32x2r_t v = {lo, hi}; bf16x2r_t b = __builtin_convertvector(v, bf16x2r_t); return __builtin_bit_cast(unsigned, b); }
DI void ld8f(const float* p, float (&o)[8]) { const f32x4 a = *(const f32x4*)p, b = *(const f32x4*)(p + 4); o[0] = a[0]; o[1] = a[1]; o[2] = a[2]; o[3] = a[3]; o[4] = b[0]; o[5] = b[1]; o[6] = b[2]; o[7] = b[3]; }
DI void ld8b(const bf16_t* p, float (&o)[8]) { const u32x4 w = *(const u32x4*)p;
#pragma unroll
    for (int i = 0; i < 4; ++i) { o[2 * i] = bf2f(w[i] & 0xffffu); o[2 * i + 1] = bf2f(w[i] >> 16); } }
DI u32x4 pk8(const float (&v)[8]) { return (u32x4){cvtpk_r(v[0], v[1]), cvtpk_r(v[2], v[3]), cvtpk_r(v[4], v[5]), cvtpk_r(v[6], v[7])}; }
template <int R>
DI void row_pass(const RowArgs& a, int row0, int rstride, int lane) {
    float x[R][2][8], y[R][2][8]; int rows[R]; bool ok[R];
#pragma unroll
    for (int i = 0; i < R; ++i) { rows[i] = row0 + i * rstride; ok[i] = rows[i] < a.nrows; if (!ok[i]) rows[i] = row0; }
#pragma unroll
    for (int i = 0; i < R; ++i) { const int row = rows[i]; const bool lat = row < MLAT;
#pragma unroll
        for (int j = 0; j < 2; ++j) { const int c = (64 * j + lane) * 8;
            if (a.xold_b) ld8b(a.xold_b + (size_t)row * D + c, x[i][j]);
            else ld8f((lat ? a.xold_lat + (size_t)row * D : a.xold_ctx + (size_t)(row - MLAT) * D) + c, x[i][j]);
            if (a.y) {
                if (a.yslab && !lat) { const bf16_t* ys = a.yslab + (size_t)(row - MLAT) * D + c; float t1[8], t2[8], t3[8];
                    ld8b(ys, y[i][j]); ld8b(ys + (size_t)MCTX * D, t1); ld8b(ys + (size_t)2 * MCTX * D, t2); ld8b(ys + (size_t)3 * MCTX * D, t3);
#pragma unroll
                    for (int e = 0; e < 8; ++e) y[i][j][e] = (y[i][j][e] + t1[e]) + (t2[e] + t3[e]); }
                else ld8b(a.y + (size_t)row * D + c, y[i][j]); } } }
    const int s0 = rows[0] < MLAT ? rows[0] / T : 16;
    float gy[2][8], gt[2][8], gu[2][8], sh[2][8], sc[2][8];
#pragma unroll
    for (int j = 0; j < 2; ++j) { const int c = (64 * j + lane) * 8;
        if (a.y) { ld8f(a.gY + c, gy[j]); ld8f(a.mods + (size_t)s0 * 6144 + a.gidx * D + c, gt[j]); }
        if (a.u) { ld8f(a.gU + c, gu[j]); ld8f(a.modsU + (size_t)s0 * 6144 + a.sidx * D + c, sh[j]); ld8f(a.modsU + (size_t)s0 * 6144 + (a.sidx + 1) * D + c, sc[j]); } }
    if (a.y) {
        float ss[R];
#pragma unroll
        for (int i = 0; i < R; ++i) { ss[i] = 0.f;
#pragma unroll
            for (int j = 0; j < 2; ++j)
#pragma unroll
                for (int e = 0; e < 8; ++e) ss[i] += y[i][j][e] * y[i][j][e]; }
#pragma unroll
        for (int o = 1; o < 64; o <<= 1)
#pragma unroll
            for (int i = 0; i < R; ++i) ss[i] += __shfl_xor(ss[i], o);
#pragma unroll
        for (int i = 0; i < R; ++i) { const int row = rows[i]; const bool lat = row < MLAT;
            const float r = rsqrtf(ss[i] * (1.f / D) + EPS);
#pragma unroll
            for (int j = 0; j < 2; ++j) { const int c = (64 * j + lane) * 8;
#pragma unroll
                for (int e = 0; e < 8; ++e) x[i][j][e] += gt[j][e] * (y[i][j][e] * r * gy[j][e]);
                if (ok[i]) {
                    if (lat ? a.xnew_lat != nullptr : a.xnew_ctx != nullptr) { float* xn = (lat ? a.xnew_lat + (size_t)row * D : a.xnew_ctx + (size_t)(row - MLAT) * D) + c;
                        *(f32x4*)xn = (f32x4){x[i][j][0], x[i][j][1], x[i][j][2], x[i][j][3]}; *(f32x4*)(xn + 4) = (f32x4){x[i][j][4], x[i][j][5], x[i][j][6], x[i][j][7]}; }
                    if (a.xnew_b) { const u32x4 w = pk8(x[i][j]); *(u32x4*)(a.xnew_b + (size_t)row * D + c) = w;
#pragma unroll
                        for (int e = 0; e < 4; ++e) { x[i][j][2 * e] = bf2f(w[e] & 0xffffu); x[i][j][2 * e + 1] = bf2f(w[e] >> 16); } } } }
        }
    }
    if (a.u) {
        float ss[R];
#pragma unroll
        for (int i = 0; i < R; ++i) { ss[i] = 0.f;
#pragma unroll
            for (int j = 0; j < 2; ++j)
#pragma unroll
                for (int e = 0; e < 8; ++e) ss[i] += x[i][j][e] * x[i][j][e]; }
#pragma unroll
        for (int o = 1; o < 64; o <<= 1)
#pragma unroll
            for (int i = 0; i < R; ++i) ss[i] += __shfl_xor(ss[i], o);
#pragma unroll
        for (int i = 0; i < R; ++i) { const int row = rows[i];
            const float r = rsqrtf(ss[i] * (1.f / D) + EPS);
            if (ok[i]) {
#pragma unroll
                for (int j = 0; j < 2; ++j) { const int c = (64 * j + lane) * 8; float o[8];
#pragma unroll
                    for (int e = 0; e < 8; ++e) o[e] = (x[i][j][e] * r * gu[j][e]) * (sc[j][e] + 1.f) + sh[j][e];
                    *(u32x4*)(a.u + (size_t)row * D + c) = pk8(o); } } }
    }
}
DI void phase_rows(const RowArgs& a, int vcu, int G) {
    constexpr int R = 2;
    const int tidr = tid_fresh(); const int lane = tidr & 63; const int gw = vcu * NWAVES + (tidr >> 6), NGW = G * NWAVES;
    for (int row = R * gw; row < a.nrows; row += R * NGW) row_pass<R>(a, row, 1, lane);
}

typedef float f32x16 __attribute__((ext_vector_type(16)));
typedef short s16x4 __attribute__((ext_vector_type(4)));
typedef float f32x2_t __attribute__((ext_vector_type(2))); typedef __bf16 bf16x2_t __attribute__((ext_vector_type(2)));
DI unsigned cvtpk(float lo, float hi) { f32x2_t v = {lo, hi}; bf16x2_t b = __builtin_convertvector(v, bf16x2_t); return __builtin_bit_cast(unsigned, b); }
DI s16x4 tr16(const LAS unsigned char* p) { return __builtin_bit_cast(s16x4, __builtin_amdgcn_ds_read_tr16_b64_v4i16((LAS s16x4*)p)); }
DI int crow(int i, int hi) { return (i & 3) + 8 * (i >> 2) + 4 * hi; }
constexpr float LOG2E = 1.4426950408889634f;
DI int swap23(int q) { return (q & 3) | ((q & 4) << 1) | ((q & 8) >> 1); }
DI int scan_rbase(int b, int dir, int n) { return n < 8 ? MLAT + b * LC + (dir ? LC - 1 - 32 * n : 32 * n) : b * T + (dir ? T - 1 - 32 * (n - 8) : 32 * (n - 8)); }
DI bf16x8 pack8(const f32x16& x, int s) { u32x4 p; p.x = cvtpk(x[8 * s], x[8 * s + 1]); p.y = cvtpk(x[8 * s + 2], x[8 * s + 3]); p.z = cvtpk(x[8 * s + 4], x[8 * s + 5]); p.w = cvtpk(x[8 * s + 6], x[8 * s + 7]); return __builtin_bit_cast(bf16x8, p); }
struct ScanRaw { u32x4 q[2], z[2], v[2]; };
DI float dpp_shr_f(float old, float v, int n) {
    const int o = __builtin_bit_cast(int, old), x = __builtin_bit_cast(int, v); int r;
    switch (n) { case 1: r = __builtin_amdgcn_update_dpp(o, x, 0x111, 0xf, 0xf, false); break; case 2: r = __builtin_amdgcn_update_dpp(o, x, 0x112, 0xf, 0xf, false); break;
                 case 4: r = __builtin_amdgcn_update_dpp(o, x, 0x114, 0xf, 0xf, false); break; default: r = __builtin_amdgcn_update_dpp(o, x, 0x118, 0xf, 0xf, false); break; }
    return __builtin_bit_cast(float, r); }
DI void unpack8(const u32x4& w, float (&o)[8]) {
#pragma unroll
    for (int i = 0; i < 4; ++i) { o[2 * i] = bf2f(w[i] & 0xffffu); o[2 * i + 1] = bf2f(w[i] >> 16); } }
template <int KD>
DI void scan_load(ScanRaw& R, const bf16_t* __restrict__ F, int b, int hh, int dir, int n, int ptid, int lane, int pw) {
    const int rb = scan_rbase(b, dir, n), st = dir ? -1 : 1;
    if (KD == 128) { const int tp = lane & 15, cg = pw * 4 + (lane >> 4);
#pragma unroll
        for (int e = 0; e < 2; ++e) { const bf16_t* f = F + (size_t)(rb + st * (2 * tp + e)) * NF + hh * 128 + cg * 8;
            R.q[e] = *(const u32x4*)(f + F_AQ); R.z[e] = *(const u32x4*)(f + (dir ? F_AZB : F_AZF)); } }
    else { const int cg = ptid >> 5, tok = ptid & 31; const bf16_t* f = F + (size_t)(rb + st * tok) * NF + hh * 64 + cg * 8;
        R.q[0] = *(const u32x4*)(f + F_BQ); R.q[1] = *(const u32x4*)(f + F_BK); }
#pragma unroll
    for (int i = 0; i < 2; ++i) { const int e = ptid + 256 * i, p = e >> 4, vc8 = e & 15;
        R.v[i] = *(const u32x4*)(F + (size_t)(rb + st * p) * NF + (KD == 128 ? F_AI : F_BV) + hh * 128 + 8 * vc8); }
}
template <int KD>
DI void scan_process(const ScanRaw& R, LAS unsigned char* buf, int ptid, int lane, int pw, const LAS float* gx, const float (&cst)[8]) {
    constexpr int QSTR = KD * 2 + 16, QDB = 32 * QSTR, OFF_KE = QDB, OFF_V = 2 * QDB, OFF_DK = OFF_V + 8192;
    if (KD == 128) {
        const int tp = lane & 15, cg = pw * 4 + (lane >> 4);
        float k0[8], k1[8], q0[8], q1[8], inc[8];
        unpack8(R.z[0], k0); unpack8(R.z[1], k1); unpack8(R.q[0], q0); unpack8(R.q[1], q1);
#pragma unroll
        for (int i = 0; i < 8; ++i) inc[i] = (1.f - k0[i]) * (1.f - k1[i]);
#pragma unroll
        for (int d = 1; d < 16; d <<= 1)
#pragma unroll
            for (int i = 0; i < 8; ++i) inc[i] *= dpp_shr_f(1.f, inc[i], d);
        float o0[8], o1[8], e0[8], e1[8], pl[8];
#pragma unroll
        for (int i = 0; i < 8; ++i) { const float ex = dpp_shr_f(1.f, inc[i], 1); pl[i] = __shfl(inc[i], lane | 15);
            const float c0 = ex * (1.f - k0[i]), c1 = inc[i]; const float rp = __builtin_amdgcn_rcpf(pl[i]);
            o0[i] = q0[i] * (c0 * rp); o1[i] = q1[i] * (c1 * rp); e0[i] = k0[i] * (pl[i] * __builtin_amdgcn_rcpf(c0)); e1[i] = k1[i] * (pl[i] * __builtin_amdgcn_rcpf(c1)); }
        LAS unsigned char* p0 = buf + (2 * tp) * QSTR + cg * 16;
        *(LAS u32x4*)p0 = (u32x4){cvtpk(o0[0], o0[1]), cvtpk(o0[2], o0[3]), cvtpk(o0[4], o0[5]), cvtpk(o0[6], o0[7])};
        *(LAS u32x4*)(p0 + QSTR) = (u32x4){cvtpk(o1[0], o1[1]), cvtpk(o1[2], o1[3]), cvtpk(o1[4], o1[5]), cvtpk(o1[6], o1[7])};
        *(LAS u32x4*)(p0 + OFF_KE) = (u32x4){cvtpk(e0[0], e0[1]), cvtpk(e0[2], e0[3]), cvtpk(e0[4], e0[5]), cvtpk(e0[6], e0[7])};
        *(LAS u32x4*)(p0 + OFF_KE + QSTR) = (u32x4){cvtpk(e1[0], e1[1]), cvtpk(e1[2], e1[3]), cvtpk(e1[4], e1[5]), cvtpk(e1[6], e1[7])};
        if (tp == 0) { *(LAS f32x4*)(buf + OFF_DK + cg * 32) = (f32x4){pl[0], pl[1], pl[2], pl[3]}; *(LAS f32x4*)(buf + OFF_DK + cg * 32 + 16) = (f32x4){pl[4], pl[5], pl[6], pl[7]}; }
    } else {
        const int cg = ptid >> 5, tok = ptid & 31;
        float bc[8], q[8], k[8], bl[8];
        unpack8(R.q[0], q); unpack8(R.q[1], k);
#pragma unroll
        for (int i = 0; i < 8; ++i) { const float x = gx[(cg * 8 + i) * 32 + tok] + cst[i]; const float e = __builtin_amdgcn_exp2f(-LOG2E * fabsf(x));
            bc[i] = (fminf(x, 0.f) * LOG2E - __builtin_amdgcn_logf(1.f + e)) * (1.f / 16.f); }
#pragma unroll
        for (int d = 1; d < 16; d <<= 1)
#pragma unroll
            for (int i = 0; i < 8; ++i) bc[i] += dpp_shr_f(0.f, bc[i], d);
#pragma unroll
        for (int i = 0; i < 8; ++i) { const float t0 = __shfl(bc[i], (lane & 32) + 15); if (lane & 16) bc[i] += t0; bl[i] = __shfl(bc[i], lane | 31); }
        float o[8], e[8];
#pragma unroll
        for (int i = 0; i < 8; ++i) { const float w = __builtin_amdgcn_exp2f(bl[i] - bc[i]); e[i] = k[i] * w; o[i] = q[i] * 0.125f * __builtin_amdgcn_rcpf(w); }
        LAS unsigned char* p0 = buf + tok * QSTR + cg * 16;
        *(LAS u32x4*)p0 = (u32x4){cvtpk(o[0], o[1]), cvtpk(o[2], o[3]), cvtpk(o[4], o[5]), cvtpk(o[6], o[7])};
        *(LAS u32x4*)(p0 + OFF_KE) = (u32x4){cvtpk(e[0], e[1]), cvtpk(e[2], e[3]), cvtpk(e[4], e[5]), cvtpk(e[6], e[7])};
        if (tok == 0) { *(LAS f32x4*)(buf + OFF_DK + cg * 32) = (f32x4){__builtin_amdgcn_exp2f(bl[0]), __builtin_amdgcn_exp2f(bl[1]), __builtin_amdgcn_exp2f(bl[2]), __builtin_amdgcn_exp2f(bl[3])};
            *(LAS f32x4*)(buf + OFF_DK + cg * 32 + 16) = (f32x4){__builtin_amdgcn_exp2f(bl[4]), __builtin_amdgcn_exp2f(bl[5]), __builtin_amdgcn_exp2f(bl[6]), __builtin_amdgcn_exp2f(bl[7])}; }
    }
#pragma unroll
    for (int i = 0; i < 2; ++i) { const int e = ptid + 256 * i, p = e >> 4, vc8 = e & 15; *(LAS u32x4*)(buf + OFF_V + (vc8 >> 2) * 2048 + p * 64 + (vc8 & 3) * 16) = R.v[i]; }
}

#define SCAN_BAR() asm volatile("s_waitcnt lgkmcnt(0)\n\ts_barrier" ::: "memory")
DI void scan_store_o(const LAS unsigned char* ob, bf16_t* O, int b, int dir, int n, int ocol0, int tid) {
    const int tok = tid >> 4, pc = tid & 15; const int rb = scan_rbase(b, dir, n), stp = dir ? -1 : 1;
    const u32x4 w = *(const LAS u32x4*)(ob + tok * 272 + pc * 16);
    *(u32x4*)(O + (size_t)(rb + stp * tok) * D + ocol0 + pc * 8) = w;
}
template <int KD>
DI void scan_mfma_task(int b, int hh, int dir, const bf16_t* __restrict__ F, bf16_t* O, const float* w_g2, const float* b_g2, LAS unsigned char* lds) {
    constexpr int NKT = KD / 32, QSTR = KD * 2 + 16, QDB = 32 * QSTR, OFF_KE = QDB, OFF_V = 2 * QDB, OFF_DK = OFF_V + 8192, BUF = OFF_DK + KD * 4, OSTR = 272, OB0 = 2 * BUF, OBB = 32 * OSTR;
    constexpr int NCH = (LC + T) / 32; static_assert(NCH % 6 == 0, "producer loop is unrolled by 6");
    constexpr int GX0 = 73728, GXB = 8192;
    const int tid = tid_fresh(), lane = tid & 63, wid = __builtin_amdgcn_readfirstlane(tid >> 6);
    const int ocol0 = (KD == 128 ? 0 : 512) + hh * 128;
    if (wid < 4) {
        const int vt = wid, r = lane & 31, hi = lane >> 5;
        f32x16 S[NKT];
#pragma unroll
        for (int kt = 0; kt < NKT; ++kt)
#pragma unroll
            for (int i = 0; i < 16; ++i) S[kt][i] = 0.f;
        const unsigned qrd = r * QSTR + hi * 16;
        const unsigned vrd = vt * 2048 + ((lane >> 4) & 1) * 32 + (lane & 3) * 8 + (4 * hi + ((lane & 15) >> 2)) * 64;
        const unsigned ktr = (4 * hi + ((lane & 15) >> 2)) * QSTR + (((lane >> 4) & 1) * 16 + 8 * (lane & 1) + 4 * ((lane >> 1) & 1)) * 2;
        bf16x8 gwB[2]; bf16x8 lrA;
        const int st_ = dir ? -1 : 1;
#define SCAN_LR_LOAD(c) (*(const bf16x8*)(F + (size_t)(scan_rbase(b, dir, (c)) + st_ * r) * NF + F_LR + dir * 16 + 8 * hi))
#define SCAN_GATES(c, LRV) do { f32x16 z_; _Pragma("unroll") for (int i_ = 0; i_ < 16; ++i_) z_[i_] = 0.f; \
            LAS unsigned char* gs_ = lds + GX0 + ((c) & 1) * GXB; \
            _Pragma("unroll") for (int tl_ = 0; tl_ < 2; ++tl_) { const f32x16 gx_ = __builtin_amdgcn_mfma_f32_32x32x16_bf16(LRV, gwB[tl_], z_, 0, 0, 0); \
                _Pragma("unroll") for (int g4_ = 0; g4_ < 4; ++g4_) *(LAS f32x4*)(gs_ + ((tl_ * 32 + r) * 32 + 8 * g4_ + 4 * hi) * 4) = (f32x4){gx_[4 * g4_], gx_[4 * g4_ + 1], gx_[4 * g4_ + 2], gx_[4 * g4_ + 3]}; } } while (0)
        if (KD == 64 && vt == 0) {
#pragma unroll
            for (int tl = 0; tl < 2; ++tl) { float wv[8];
#pragma unroll
                for (int j = 0; j < 8; ++j) wv[j] = w_g2[(size_t)(dir * 16 + 8 * hi + j) * 256 + hh * 64 + tl * 32 + r];
                const u32x4 wp = (u32x4){cvtpk(wv[0], wv[1]), cvtpk(wv[2], wv[3]), cvtpk(wv[4], wv[5]), cvtpk(wv[6], wv[7])}; gwB[tl] = __builtin_bit_cast(bf16x8, wp); }
            const bf16x8 l0 = SCAN_LR_LOAD(0), l1 = SCAN_LR_LOAD(1); lrA = SCAN_LR_LOAD(2);
            SCAN_GATES(0, l0); SCAN_GATES(1, l1);
        }
        SCAN_BAR();
        SCAN_BAR();
        for (int n = 0; n < NCH; ++n) {
            const LAS unsigned char* B0 = lds + (n & 1) * BUF;
            if (KD == 64 && vt == 0 && n + 2 < NCH) { const bf16x8 cur_ = lrA; if (n + 3 < NCH) lrA = SCAN_LR_LOAD(n + 3); SCAN_GATES(n + 2, cur_); }
            if (n > 0) scan_store_o(lds + OB0 + ((n - 1) & 1) * OBB, O, b, dir, n - 1, ocol0, tid);
            { f32x4 dk[NKT][4];
#pragma unroll
              for (int kt = 0; kt < NKT; ++kt)
#pragma unroll
                  for (int g4 = 0; g4 < 4; ++g4) dk[kt][g4] = *(const LAS f32x4*)(B0 + OFF_DK + (kt * 32 + 16 * (g4 >> 1) + 8 * hi + 4 * (g4 & 1)) * 4);
              __builtin_amdgcn_sched_barrier(0);
#pragma unroll
              for (int kt = 0; kt < NKT; ++kt)
#pragma unroll
                  for (int g4 = 0; g4 < 4; ++g4) { S[kt][4 * g4] *= dk[kt][g4][0]; S[kt][4 * g4 + 1] *= dk[kt][g4][1]; S[kt][4 * g4 + 2] *= dk[kt][g4][2]; S[kt][4 * g4 + 3] *= dk[kt][g4][3]; } }
            f32x16 o, sc;
#pragma unroll
            for (int i = 0; i < 16; ++i) { o[i] = 0.f; sc[i] = 0.f; }
            { bf16x8 qd[2 * NKT], ke[2 * NKT];
#pragma unroll
              for (int ks = 0; ks < 2 * NKT; ++ks) { qd[ks] = *(const LAS bf16x8*)(B0 + qrd + ks * 32); ke[ks] = *(const LAS bf16x8*)(B0 + OFF_KE + qrd + ks * 32); }
              __builtin_amdgcn_sched_barrier(0);
#pragma unroll
              for (int kt = 0; kt < NKT; ++kt)
#pragma unroll
                  for (int s2 = 0; s2 < 2; ++s2) { o = __builtin_amdgcn_mfma_f32_32x32x16_bf16(qd[2 * kt + s2], pack8(S[kt], s2), o, 0, 0, 0);
                      sc = __builtin_amdgcn_mfma_f32_32x32x16_bf16(ke[2 * kt + s2], qd[2 * kt + s2], sc, 0, 0, 0); } }
            { s16x4 vlo[2], vhi[2], klo[NKT][2], khi[NKT][2];
#pragma unroll
              for (int s2 = 0; s2 < 2; ++s2) { vlo[s2] = tr16(B0 + OFF_V + vrd + s2 * 1024); vhi[s2] = tr16(B0 + OFF_V + vrd + s2 * 1024 + 512); }
#pragma unroll
              for (int kt = 0; kt < NKT; ++kt)
#pragma unroll
                  for (int s2 = 0; s2 < 2; ++s2) { const LAS unsigned char* kp = B0 + OFF_KE + ktr + kt * 64 + s2 * (16 * QSTR); klo[kt][s2] = tr16(kp); khi[kt][s2] = tr16(kp + 8 * QSTR); }
              __builtin_amdgcn_sched_barrier(0);
#pragma unroll
              for (int i = 0; i < 16; ++i) if (crow(i, hi) > r) sc[i] = 0.f;
              bf16x8 vb[2];
#pragma unroll
              for (int s2 = 0; s2 < 2; ++s2) vb[s2] = (bf16x8){vlo[s2][0], vlo[s2][1], vlo[s2][2], vlo[s2][3], vhi[s2][0], vhi[s2][1], vhi[s2][2], vhi[s2][3]};
#pragma unroll
              for (int s2 = 0; s2 < 2; ++s2) o = __builtin_amdgcn_mfma_f32_32x32x16_bf16(pack8(sc, s2), vb[s2], o, 0, 0, 0);
#pragma unroll
              for (int kt = 0; kt < NKT; ++kt)
#pragma unroll
                  for (int s2 = 0; s2 < 2; ++s2) { const bf16x8 ket = (bf16x8){klo[kt][s2][0], klo[kt][s2][1], klo[kt][s2][2], klo[kt][s2][3], khi[kt][s2][0], khi[kt][s2][1], khi[kt][s2][2], khi[kt][s2][3]};
                      S[kt] = __builtin_amdgcn_mfma_f32_32x32x16_bf16(ket, vb[s2], S[kt], 0, 0, 0); } }
            { LAS unsigned char* ob = lds + OB0 + (n & 1) * OBB + (vt * 32 + r) * 2;
#pragma unroll
              for (int i = 0; i < 16; ++i) *(LAS unsigned short*)(ob + crow(i, hi) * OSTR) = (unsigned short)cvtpk(o[i], o[i]); }
            SCAN_BAR();
        }
        scan_store_o(lds + OB0 + ((NCH - 1) & 1) * OBB, O, b, dir, NCH - 1, ocol0, tid);
#undef SCAN_LR_LOAD
#undef SCAN_GATES
    } else {
        const int ptid = tid - 256, pw = wid - 4;
        ScanRaw r0, r1, r2;
        scan_load<KD>(r0, F, b, hh, dir, 0, ptid, lane, pw);
        scan_load<KD>(r1, F, b, hh, dir, 1, ptid, lane, pw);
        scan_load<KD>(r2, F, b, hh, dir, 2, ptid, lane, pw);
        float cst[8];
#pragma unroll
        for (int i = 0; i < 8; ++i) cst[i] = KD == 64 ? b_g2[dir * 256 + hh * 64 + (ptid >> 5) * 8 + i] : 0.f;
        const LAS float* gx0 = (const LAS float*)(lds + GX0); const LAS float* gx1 = (const LAS float*)(lds + GX0 + GXB);
        SCAN_BAR();
        scan_process<KD>(r0, lds, ptid, lane, pw, gx0, cst);
        SCAN_BAR();
#define SCAN_IT(nn, LD, PR, BOFF) do { if ((nn) > 0) scan_store_o(lds + OB0 + (((nn) - 1) & 1) * OBB, O, b, dir, (nn) - 1, ocol0, tid); \
            if ((nn) + 3 < NCH) scan_load<KD>(LD, F, b, hh, dir, (nn) + 3, ptid, lane, pw); \
            if ((nn) + 1 < NCH) scan_process<KD>(PR, lds + (BOFF), ptid, lane, pw, (BOFF) ? gx1 : gx0, cst); SCAN_BAR(); } while (0)
        for (int n = 0; n < NCH; n += 6) {
            SCAN_IT(n,     r0, r1, BUF);
            SCAN_IT(n + 1, r1, r2, 0);
            SCAN_IT(n + 2, r2, r0, BUF);
            SCAN_IT(n + 3, r0, r1, 0);
            SCAN_IT(n + 4, r1, r2, BUF);
            SCAN_IT(n + 5, r2, r0, 0);
        }
#undef SCAN_IT
        scan_store_o(lds + OB0 + ((NCH - 1) & 1) * OBB, O, b, dir, NCH - 1, ocol0, tid);
    }
}

DI float silu_fastc(float x) { return x * __builtin_amdgcn_rcpf(1.f + __builtin_amdgcn_exp2f(-1.4426950408889634f * x)); }
DI void phase_combine(const bf16_t* Of, const bf16_t* Ob, const bf16_t* __restrict__ F, const float* gn_a, const float* gn_b, bf16_t* Yg, int vcu, int G) {
    const int tidm = tid_fresh(); const int lane = tidm & 63; const int gw = vcu * NWAVES + (tidm >> 6), NGW = G * NWAVES;
    const int c0 = 16 * lane; const int fc = c0 < 512 ? F_AOG + c0 : F_BR + (c0 - 512);
    float gnv[16];
#pragma unroll
    for (int i = 0; i < 16; ++i) gnv[i] = (c0 < 512 ? gn_a : gn_b)[(c0 & 127) + i];
    for (int row0 = 2 * gw; row0 < MALL; row0 += 2 * NGW) {
        u32x4 av[2][2], bv[2][2], gv[2][2];
#pragma unroll
        for (int i = 0; i < 2; ++i) { const size_t row = row0 + i;
            av[i][0] = *(const u32x4*)(Of + row * D + c0); av[i][1] = *(const u32x4*)(Of + row * D + c0 + 8);
            bv[i][0] = *(const u32x4*)(Ob + row * D + c0); bv[i][1] = *(const u32x4*)(Ob + row * D + c0 + 8);
            gv[i][0] = *(const u32x4*)(F + row * NF + fc); gv[i][1] = *(const u32x4*)(F + row * NF + fc + 8); }
#pragma unroll
        for (int i = 0; i < 2; ++i) { const size_t row = row0 + i; float o[16], gt[16]; float ss = 0.f;
#pragma unroll
            for (int h2 = 0; h2 < 2; ++h2)
#pragma unroll
                for (int e = 0; e < 4; ++e) { o[8 * h2 + 2 * e] = bf2f(av[i][h2][e] & 0xffffu) + bf2f(bv[i][h2][e] & 0xffffu); o[8 * h2 + 2 * e + 1] = bf2f(av[i][h2][e] >> 16) + bf2f(bv[i][h2][e] >> 16);
                    gt[8 * h2 + 2 * e] = bf2f(gv[i][h2][e] & 0xffffu); gt[8 * h2 + 2 * e + 1] = bf2f(gv[i][h2][e] >> 16); }
#pragma unroll
            for (int e = 0; e < 16; ++e) ss += o[e] * o[e];
            ss += __shfl_xor(ss, 1); ss += __shfl_xor(ss, 2); ss += __shfl_xor(ss, 4);
            const float r = rsqrtf(ss * (1.f / 128.f) + EPS);
            unsigned wv[8];
#pragma unroll
            for (int e = 0; e < 8; ++e) wv[e] = cvtpk_r(o[2 * e] * r * gnv[2 * e] * silu_fastc(gt[2 * e]), o[2 * e + 1] * r * gnv[2 * e + 1] * silu_fastc(gt[2 * e + 1]));
            *(u32x4*)(Yg + row * D + c0) = (u32x4){wv[0], wv[1], wv[2], wv[3]}; *(u32x4*)(Yg + row * D + c0 + 8) = (u32x4){wv[4], wv[5], wv[6], wv[7]}; }
    }
}

constexpr int AT_KB = 9216, AT_VB = 8192, AT_K0 = 0, AT_V0 = 2 * AT_KB, AT_Q0 = AT_V0 + 2 * AT_VB, AT_K2 = AT_Q0 + 8 * 9216, AT_V2 = AT_K2 + AT_KB;
static_assert(AT_V2 + AT_VB <= LDS_BYTES - 64, "attention LDS");
constexpr int AT_DUMMY_ = 0;

DI void attn_tile_src(int t, int b, int kv, int blk, bool hasp, bool hasn, const bf16_t* Kl, const bf16_t* Vl, const bf16_t* Kc, const bf16_t* Vc, const bf16_t*& kp, const bf16_t*& vp, int& type, int& te) {
    size_t row0; const bf16_t *kb_ = Kl, *vb_ = Vl;
    if (t < 2) { row0 = (size_t)b * T + blk * 128 + t * 64; type = 0; te = 0; }
    else if (t < 6) { row0 = (size_t)b * LC + (t - 2) * 64; kb_ = Kc; vb_ = Vc; type = 0; te = 0; }
    else { const int e = t - 6;
        if (hasp && e == 0) { row0 = (size_t)b * T + (blk - 1) * 128 + 64; type = 1; te = 1; }
        else if (hasn && e == (hasp ? 1 : 0)) { row0 = (size_t)b * T + (blk + 1) * 128; type = 2; te = 0; }
        else { row0 = (size_t)b * T + (hasp ? blk - 1 : blk) * 128; type = 1; te = 0; } }
    kp = kb_ + row0 * 256 + kv * 64; vp = vb_ + row0 * 256 + kv * 64;
}

DI void attn_phase(const bf16_t* __restrict__ Q, const bf16_t* __restrict__ Kl, const bf16_t* __restrict__ Vl, const bf16_t* __restrict__ Kc, const bf16_t* __restrict__ Vc,
                   const float* sink, bf16_t* O, LAS unsigned char* lds, int vcu, int G) {
    const int tid = tid_fresh(), lane = tid & 63, wid = __builtin_amdgcn_readfirstlane(tid >> 6), r = lane & 31, hi = lane >> 5;
    const int skey = tid >> 3, sc = tid & 7;
    const unsigned kwr = skey * 144 + sc * 16, vwr = (sc >> 2) * 4096 + skey * 64 + (sc & 3) * 16;
    const unsigned krd = r * 144 + hi * 16;
    const unsigned vrd = ((lane >> 4) & 1) * 32 + (lane & 3) * 8 + (4 * hi + ((lane & 15) >> 2)) * 64;
    const int g = wid >> 1, qhalf = wid & 1;
    LAS unsigned char* Qw = lds + AT_Q0 + wid * 9216;
    const float NEG = -1e30f;
    for (int unit = vcu; unit < NB * 4 * 16; unit += G) {
        const int blk = unit & 15, kv = (unit >> 4) & 3, b = unit >> 6, h = kv * 4 + g;
        const bool hasp = blk > 0, hasn = blk < 15; const int NT = 7 + (hasp ? 1 : 0) + (hasn ? 1 : 0);
        const size_t qrow0 = (size_t)b * T + blk * 128 + qhalf * 64;
        const bf16_t *kp, *vp; int type, te;
        attn_tile_src(0, b, kv, blk, hasp, hasn, Kl, Vl, Kc, Vc, kp, vp, type, te);
        u32x4 kreg2 = {0u, 0u, 0u, 0u}, vreg2 = {0u, 0u, 0u, 0u};
        u32x4 kreg = *(const u32x4*)(kp + (size_t)skey * 256 + sc * 8), vreg = *(const u32x4*)(vp + (size_t)skey * 256 + sc * 8);
        { u32x4 qv[8];
#pragma unroll
          for (int i = 0; i < 8; ++i) qv[i] = *(const u32x4*)(Q + (qrow0 + i * 8 + (lane >> 3)) * 1024 + h * 64 + (lane & 7) * 8);
#pragma unroll
          for (int i = 0; i < 8; ++i) *(LAS u32x4*)(Qw + (i * 8 + (lane >> 3)) * 144 + (lane & 7) * 16) = qv[i]; }
        *(LAS u32x4*)(lds + AT_K0 + kwr) = kreg; *(LAS u32x4*)(lds + AT_V0 + vwr) = vreg;
        int typen, ten;
        attn_tile_src(1, b, kv, blk, hasp, hasn, Kl, Vl, Kc, Vc, kp, vp, typen, ten);
        kreg = *(const u32x4*)(kp + (size_t)skey * 256 + sc * 8); vreg = *(const u32x4*)(vp + (size_t)skey * 256 + sc * 8);
        u32x4 kregn = kreg, vregn = vreg;
        f32x16 ot[2][2];
#pragma unroll
        for (int dh = 0; dh < 2; ++dh)
#pragma unroll
            for (int qt = 0; qt < 2; ++qt)
#pragma unroll
                for (int i = 0; i < 16; ++i) ot[dh][qt][i] = 0.f;
        float m[2] = {0.f, 0.f}, l[2] = {0.f, 0.f};
        __syncthreads();
        for (int t = 0; t < NT; ++t) {
            const int cur = t & 1; const int stype = type, ste = te; const bool fin = t == NT - 1, nfin = t + 1 == NT - 1, nnfin = t + 2 == NT - 1;
            int typenn = 0, tenn = 0;
            if (t + 2 < NT) { attn_tile_src(t + 2, b, kv, blk, hasp, hasn, Kl, Vl, Kc, Vc, kp, vp, typenn, tenn);
                if (!nnfin || hasp) { kregn = *(const u32x4*)(kp + (size_t)skey * 256 + sc * 8); vregn = *(const u32x4*)(vp + (size_t)skey * 256 + sc * 8); }
                if (nnfin && hasn) { const size_t o2 = ((size_t)b * T + (blk + 1) * 128 + 64 + skey) * 256 + kv * 64 + sc * 8; kreg2 = *(const u32x4*)(Kl + o2); vreg2 = *(const u32x4*)(Vl + o2); } }
            const LAS unsigned char* Kb = fin && qhalf ? lds + AT_K2 : lds + AT_K0 + cur * AT_KB; const LAS unsigned char* Vb = fin && qhalf ? lds + AT_V2 : lds + AT_V0 + cur * AT_VB;
            const int ttype = fin ? (qhalf ? 2 : 1) : stype;
            const int cls = fin ? ((qhalf ? hasn : hasp) ? 1 : 2) : (stype == 0 ? 0 : (ste == qhalf ? 1 : 0));
            if (cls != 2) {
#pragma unroll
            for (int qt = 0; qt < 2; ++qt) {
                f32x16 st[2];
                const bool deado = cls == 1 && ((ttype == 1) == (qt == 1));
#pragma unroll
                for (int kt = 0; kt < 2; ++kt) {
                    if (kt != qt && deado) {
#pragma unroll
                        for (int i = 0; i < 16; ++i) st[kt][i] = NEG;
                    } else {
#pragma unroll
                        for (int i = 0; i < 16; ++i) st[kt][i] = -m[qt];
#pragma unroll
                        for (int ds = 0; ds < 4; ++ds) { const bf16x8 kf = *(const LAS bf16x8*)(Kb + krd + kt * (32 * 144) + ds * 32);
                            const bf16x8 qf = *(const LAS bf16x8*)(Qw + krd + qt * (32 * 144) + ds * 32);
                            st[kt] = __builtin_amdgcn_mfma_f32_32x32x16_bf16(kf, qf, st[kt], 0, 0, 0); }
                    }
                }
                if (cls == 1) {
                    const int thr = r - 4 * hi;
                    if (ttype == 1) {
#pragma unroll
                        for (int i = 0; i < 16; ++i) { const int ci = (i & 3) + 8 * (i >> 2); st[qt][i] = ci >= thr ? st[qt][i] : NEG; }
                    } else {
#pragma unroll
                        for (int i = 0; i < 16; ++i) { const int ci = (i & 3) + 8 * (i >> 2); st[qt][i] = ci <= thr ? st[qt][i] : NEG; }
                    }
                }
                float mt = fmaxf(fmaxf(st[0][0], st[0][1]), st[1][0]);
#pragma unroll
                for (int i = 2; i < 16; i += 2) mt = fmaxf(fmaxf(mt, st[0][i]), st[0][i + 1]);
#pragma unroll
                for (int i = 1; i < 15; i += 2) mt = fmaxf(fmaxf(mt, st[1][i]), st[1][i + 1]);
                mt = fmaxf(mt, st[1][15]);
                mt = fmaxf(mt, __shfl_xor(mt, 32));
                if (__any(mt > 8.f)) {
                    const float dl = fmaxf(mt, 0.f), alpha = __builtin_amdgcn_exp2f(-dl); m[qt] += dl; l[qt] *= alpha;
#pragma unroll
                    for (int kt = 0; kt < 2; ++kt)
#pragma unroll
                        for (int i = 0; i < 16; ++i) st[kt][i] -= dl;
#pragma unroll
                    for (int dh = 0; dh < 2; ++dh)
#pragma unroll
                        for (int i = 0; i < 16; ++i) ot[dh][qt][i] *= alpha; }
                f32x2_t ps2 = {0.f, 0.f};
                u32x4 pf[2][2];
#pragma unroll
                for (int kt = 0; kt < 2; ++kt) {
                    if (kt != qt && deado) continue;
#pragma unroll
                    for (int i = 0; i < 16; i += 2) { f32x2_t p; p.x = __builtin_amdgcn_exp2f(st[kt][i]); p.y = __builtin_amdgcn_exp2f(st[kt][i + 1]); st[kt][i] = p.x; st[kt][i + 1] = p.y; ps2 = ps2 + p; }
#pragma unroll
                    for (int s = 0; s < 2; ++s)
#pragma unroll
                        for (int j = 0; j < 4; ++j) pf[kt][s][j] = cvtpk(st[kt][8 * s + 2 * j], st[kt][8 * s + 2 * j + 1]);
                }
                l[qt] += ps2.x + ps2.y;
#pragma unroll
                for (int dh = 0; dh < 2; ++dh)
#pragma unroll
                    for (int kt = 0; kt < 2; ++kt) {
                        if (kt != qt && deado) continue;
#pragma unroll
                        for (int s = 0; s < 2; ++s) { const LAS unsigned char* vpn = Vb + vrd + dh * 4096 + (2 * kt + s) * 1024;
                            const s16x4 lo = tr16(vpn), hh = tr16(vpn + 512);
                            const bf16x8 vf = (bf16x8){lo[0], lo[1], lo[2], lo[3], hh[0], hh[1], hh[2], hh[3]};
                            ot[dh][qt] = __builtin_amdgcn_mfma_f32_32x32x16_bf16(vf, __builtin_bit_cast(bf16x8, pf[kt][s]), ot[dh][qt], 0, 0, 0); } }
                __builtin_amdgcn_sched_barrier(0);
            }
            }
            if (t + 1 < NT) { *(LAS u32x4*)(lds + AT_K0 + (cur ^ 1) * AT_KB + kwr) = kreg; *(LAS u32x4*)(lds + AT_V0 + (cur ^ 1) * AT_VB + vwr) = vreg; }
            if (nfin) { *(LAS u32x4*)(lds + AT_K2 + kwr) = kreg2; *(LAS u32x4*)(lds + AT_V2 + vwr) = vreg2; }
            __syncthreads();
            type = typen; te = ten; typen = typenn; ten = tenn; kreg = kregn; vreg = vregn;
        }
        const float snk = sink[h] * LOG2E;
#pragma unroll
        for (int qt = 0; qt < 2; ++qt) {
            float lt = l[qt] + __shfl_xor(l[qt], 32); lt += __builtin_amdgcn_exp2f(snk - m[qt]);
            const float inv = 1.f / lt;
#pragma unroll
            for (int dh = 0; dh < 2; ++dh)
#pragma unroll
                for (int g4 = 0; g4 < 4; ++g4) { u32x2 w; w.x = cvtpk(ot[dh][qt][4 * g4] * inv, ot[dh][qt][4 * g4 + 1] * inv); w.y = cvtpk(ot[dh][qt][4 * g4 + 2] * inv, ot[dh][qt][4 * g4 + 3] * inv);
                    *(LAS u32x2*)(Qw + (qt * 32 + r) * 144 + (dh * 32 + 8 * g4 + 4 * hi) * 2) = w; }
        }
        asm volatile("s_waitcnt lgkmcnt(0)" ::: "memory");
#pragma unroll
        for (int i = 0; i < 8; ++i) { const u32x4 w = *(const LAS u32x4*)(Qw + (i * 8 + (lane >> 3)) * 144 + (lane & 7) * 16);
            *(u32x4*)(O + (qrow0 + i * 8 + (lane >> 3)) * 1024 + h * 64 + (lane & 7) * 8) = w; }
        asm volatile("s_waitcnt lgkmcnt(0)" ::: "memory");
    }
}

#define XB_TMO      128
#define XB_XCNT(j)  (256  + 64 * (j))
#define XB_XSUB(j)  (1280 + 64 * (j))
#define XB_XGEN(j)  (2304 + 64 * (j))
#define XB_TOP      3328
#define XB_TOPGEN   3392
#define XCD_BAR_WORDS 3456
#define XB_SPIN_CAP (1u << 18)

__device__ __forceinline__ unsigned xb_ld(unsigned* p)              { return __hip_atomic_load(p, __ATOMIC_RELAXED, __HIP_MEMORY_SCOPE_AGENT); }
__device__ __forceinline__ unsigned xb_add(unsigned* p, unsigned v) { return __hip_atomic_fetch_add(p, v, __ATOMIC_RELAXED, __HIP_MEMORY_SCOPE_AGENT); }
__device__ __forceinline__ unsigned xb_xcc_id() { return (unsigned)__builtin_amdgcn_s_getreg((3 << 11) | 20) & 0xFu; }
#define XB_SPIN(cond, bar) do { unsigned _sp = 0; while (cond) { __builtin_amdgcn_s_sleep(1); \
    if ((++_sp & 255u) == 0u) { if (xb_ld(&(bar)[XB_TMO])) break; if (_sp > XB_SPIN_CAP) { atomicAdd(&(bar)[XB_TMO], 1u); break; } } } } while (0)

struct XcdBarrier {
    unsigned* bar; unsigned x;
    volatile LAS unsigned* st;
};

__device__ __forceinline__ XcdBarrier xcd_barrier_post(unsigned* bar, volatile LAS unsigned* st) {
    XcdBarrier b; b.bar = bar; b.x = xb_xcc_id(); b.st = st;
    if (threadIdx.x == 0) (void)xb_add(&bar[XB_XCNT(b.x)], 1u);
    return b;
}
__device__ __forceinline__ void xcd_barrier_complete(unsigned* bar, unsigned x, unsigned& nloc, unsigned& nx) {
    const unsigned G = gridDim.x * gridDim.y * gridDim.z;
    unsigned sum, cnt, mine, sp = 0u;
    for (;;) {
        sum = 0u; cnt = 0u; mine = 0u;
#pragma unroll
        for (unsigned j = 0; j < 16; ++j) { const unsigned c = xb_ld(&bar[XB_XCNT(j)]); sum += c; cnt += (c > 0u) ? 1u : 0u; mine = (j == x) ? c : mine; }
        if (sum == G) break;
        __builtin_amdgcn_s_sleep(1);
        if ((++sp & 255u) == 0u) { if (xb_ld(&bar[XB_TMO])) break; if (sp > XB_SPIN_CAP) { atomicAdd(&bar[XB_TMO], 1u); break; } }
    }
    nloc = mine > 0u ? mine : 1u; nx = cnt > 0u ? cnt : 1u;
}

__device__ __forceinline__ void xcd_barrier(const XcdBarrier& b) {
    asm volatile("s_waitcnt vmcnt(0)" ::: "memory");
    __syncthreads();
    if (threadIdx.x == 0) {
        unsigned* bar = b.bar;
        __builtin_amdgcn_s_waitcnt(0);
        unsigned nloc = b.st[0], nx = b.st[1];
        if (nloc == 0u) { xcd_barrier_complete(bar, b.x, nloc, nx); b.st[0] = nloc; b.st[1] = nx; }
        const unsigned old = xb_add(&bar[XB_XSUB(b.x)], 1u);
        const unsigned gen = old / nloc;
        if (old + 1u == (gen + 1u) * nloc) {
            __builtin_amdgcn_fence(__ATOMIC_RELEASE, "agent");
            asm volatile("s_waitcnt vmcnt(0)" ::: "memory");
            const unsigned og = xb_add(&bar[XB_TOP], 1u);
            const unsigned tg = og / nx;
            if (og + 1u == (tg + 1u) * nx) xb_add(&bar[XB_TOPGEN], 1u);
            else XB_SPIN(xb_ld(&bar[XB_TOPGEN]) == tg, bar);
            __builtin_amdgcn_fence(__ATOMIC_ACQUIRE, "agent");
            xb_add(&bar[XB_XGEN(b.x)], 1u);
            asm volatile("s_waitcnt vmcnt(0)" ::: "memory");
        } else {
            XB_SPIN(xb_ld(&bar[XB_XGEN(b.x)]) == gen, bar);
            __builtin_amdgcn_fence(__ATOMIC_ACQUIRE, "agent");
            asm volatile("s_waitcnt vmcnt(0)" ::: "memory");
        }
    }
    __syncthreads();
}

#define GRID_SYNC() xcd_barrier(xb)
#ifndef SG_REP
#define SG_REP
#endif
template <class Epi> DI void run_gemm(LAS unsigned char* lds, const bf16_t* A, const bf16_t* Bt, int M, int N, int K, const Epi& E, int G, int wgm = 4) {
    pg8::Gemm g{A, Bt, M, N, K, K}; pg8::StaticOrder S; S.init(M, N, G, (int)blockIdx.x, wgm);
    pg8::gemm_phase<Epi, pg8::StaticOrder, true, true>(lds, g, S, E);
}

DI void run_gemm_ctx_splitk(LAS unsigned char* lds, const bf16_t* A  , const bf16_t* Bt  , int K, bf16_t* slab, int G) {
    const int nt = K / 64; const int nt0 = ((nt + 3) / 4 + 1) & ~1, nt1 = (nt - 2 * nt0) / 2;
    for (int w = blockIdx.x; w < 256; w += G) {
        const int sl = w >> 6, un = w & 63, pm = un >> 2, pn = un & 3;
        const int kt0 = sl < 2 ? sl * nt0 : 2 * nt0 + (sl - 2) * nt1, ntl = sl < 2 ? nt0 : nt1;
        pg8::Gemm g{A + (size_t)(pm * 256) * K + kt0 * 64, Bt + (size_t)(pn * 256) * K + kt0 * 64, 256, 256, ntl * 64, K};
        pg8::EpiBf16 E{slab + (size_t)sl * MCTX * D + (size_t)(pm * 256) * D + pn * 256, D, 0, 0};
        pg8::gemm_phase<pg8::EpiBf16, pg8::OneUnit, false, true>(lds, g, pg8::OneUnit{}, E);
    }
}


struct DstPlain { bf16_t* C; int ldc; DI bf16_t* at(int row, int col) const { return C + (size_t)row * ldc + col; } };
struct DstKV { bf16_t *Kc, *Vc; DI bf16_t* at(int row, int col) const { return col < 256 ? Kc + (size_t)row * 256 + col : Vc + (size_t)row * 256 + (col - 256); } };
template <int WM, int WN, int KS, int NW, class Dst>
DI void small_gemm(const bf16_t* __restrict__ A, const bf16_t* __restrict__ Bt, int M, int N, LAS unsigned char* lds, int vcu, int G, const Dst& dst) {
    constexpr int TR = 32 * WM, TC = 32 * WN * NW, CPR = KS / 8, RSTR = KS * 2 + 16, RPS = NTHREADS / CPR, NL = (TR + TC) / RPS, NS = D / KS;
    static_assert(WM * WN == NWAVES && TR % RPS == 0 && TC % RPS == 0 && (TR + TC) * RSTR <= LDS_BYTES - 64, "small_gemm shape");
    const int tid = tid_fresh(), w = tid >> 6, lane = tid & 63, l31 = lane & 31, hi = lane >> 5, wm = w % WM, wn = w / WM;
    const int nct = N / TC, njobs = (M / TR) * nct;
    const int lrow = tid / CPR, lch = tid % CPR;
    LAS unsigned char* wr = lds + lrow * RSTR + lch * 16;
    const LAS unsigned char* fa = lds + (32 * wm + l31) * RSTR + hi * 16;
    const LAS unsigned char* fb = lds + (TR + 32 * NW * wn + l31) * RSTR + hi * 16;
    __syncthreads();
    for (int j = vcu; j < njobs; j += G) {
        const int r0 = (j / nct) * TR, c0 = (j % nct) * TC;
        const bf16_t* pa = A + (size_t)(r0 + lrow) * D + lch * 8;
        const bf16_t* pb = Bt + (size_t)(c0 + lrow) * D + lch * 8;
        u32x4 pre[2][NL];
#pragma unroll
        for (int p = 0; p < 2; ++p)
#pragma unroll
            for (int i = 0; i < NL; ++i) pre[p][i] = *(const u32x4*)((RPS * i < TR ? pa + (size_t)(RPS * i) * D : pb + (size_t)(RPS * i - TR) * D) + p * KS);
        f32x16 acc[NW];
#pragma unroll
        for (int n = 0; n < NW; ++n)
#pragma unroll
            for (int i = 0; i < 16; ++i) acc[n][i] = 0.f;
#pragma unroll
        for (int st = 0; st < NS; ++st) {
#pragma unroll
            for (int i = 0; i < NL; ++i) *(LAS u32x4*)(wr + RPS * i * RSTR) = pre[st & 1][i];
            __syncthreads();
            if (st + 2 < NS) {
#pragma unroll
                for (int i = 0; i < NL; ++i) pre[st & 1][i] = *(const u32x4*)((RPS * i < TR ? pa + (size_t)(RPS * i) * D : pb + (size_t)(RPS * i - TR) * D) + (st + 2) * KS);
            }
#pragma unroll
            for (int s0 = 0; s0 < KS / 16; s0 += 8 / NW) {
                bf16x8 af[8 / NW], bf[8 / NW][NW];
#pragma unroll
                for (int s = 0; s < 8 / NW; ++s) { af[s] = *(const LAS bf16x8*)(fa + (s0 + s) * 32);
#pragma unroll
                    for (int n = 0; n < NW; ++n) bf[s][n] = *(const LAS bf16x8*)(fb + n * 32 * RSTR + (s0 + s) * 32); }
#pragma unroll
                for (int s = 0; s < 8 / NW; ++s)
#pragma unroll
                    for (int n = 0; n < NW; ++n) acc[n] = __builtin_amdgcn_mfma_f32_32x32x16_bf16(af[s], bf[s][n], acc[n], 0, 0, 0);
            }
            __syncthreads();
        }
        const size_t ldc = (size_t)(dst.at(1, 0) - dst.at(0, 0));
#pragma unroll
        for (int n = 0; n < NW; ++n) { bf16_t* cp = dst.at(r0 + 32 * wm + 4 * hi, c0 + 32 * (NW * wn + n) + l31);
#pragma unroll
            for (int i = 0; i < 16; ++i) cp[(size_t)((i & 3) + 8 * (i >> 2)) * ldc] = (bf16_t)f2bf(acc[n][i]); }
    }
}

__global__ void __launch_bounds__(NTHREADS, 2) mega_fwd(Args a) {
    extern __shared__ __attribute__((aligned(16))) unsigned char lds_raw[];
    LAS unsigned char* lds = (LAS unsigned char*)lds_raw;
    const int G = gridDim.x; const int bx = blockIdx.x; const int vcu = (G % 8 == 0) ? (bx % 8) * (G / 8) + bx / 8 : bx;
    unsigned char* ws = a.ws; float* out = a.out;
    float* mods = (float*)(ws + WS_MODS); float* xctx = (float*)(ws + WS_XCTX);
    bf16_t* U = (bf16_t*)(ws + WS_U); bf16_t* F = (bf16_t*)(ws + WS_F); bf16_t* Y = (bf16_t*)(ws + WS_Y); bf16_t* H = (bf16_t*)(ws + WS_H);
    bf16_t* Of = (bf16_t*)a.out; bf16_t* Ob = U; bf16_t* XB = (bf16_t*)(ws + WS_XB);
    const float* ng = a.norm_g;
    volatile LAS unsigned* MISC = (volatile LAS unsigned*)(lds + LDS_BYTES - 64);
    if (threadIdx.x == 0) { MISC[0] = 0u; MISC[1] = 0u; }
    __syncthreads();
    XcdBarrier xb = xcd_barrier_post((unsigned*)(ws + WS_BAR), MISC);

    phase_convert(a, lds, vcu, G); __syncthreads(); phase_adaln(a, lds, vcu, G); __syncthreads();
    GRID_SYNC();
    { RowArgs r{}; r.xold_lat = a.x; r.xold_ctx = a.ctx; r.u = U; r.gU = ng + 0 * D; r.modsU = mods; r.sidx = 0; r.nrows = MALL; phase_rows(r, vcu, G); }
    GRID_SYNC();
    run_gemm(lds, U, (const bf16_t*)(ws + WS_WRI), MALL, F_LR, D, pg8::EpiRecIn{F, NF, 0, (const float*)(ws + WS_LB), a.rec_b_g2}, G, 8);
    small_gemm<8, 1, 128, 1>(U, (const bf16_t*)(ws + WS_WRI) + (size_t)F_LR * D, MALL, 32, lds, vcu, G, DstPlain{F + F_LR, NF});
    GRID_SYNC();
    for (int task = bx; task < 256; task += G) {
        const int id = task >> 1, dir = id & 1, hh = (id >> 1) & 3, b = id >> 3;
        if (task & 1) scan_mfma_task<64>(b, hh, dir, F, dir ? Ob : Of, a.rec_w_g2, a.rec_b_g2, lds);
        else scan_mfma_task<128>(b, hh, dir, F, dir ? Ob : Of, a.rec_w_g2, a.rec_b_g2, lds);
        __syncthreads();
    }
    GRID_SYNC();
    phase_combine(Of, Ob, F, a.gn_a, a.gn_b, Ob, vcu, G);
    GRID_SYNC();
    run_gemm(lds, Ob, (const bf16_t*)(ws + WS_WRO), MLAT, D, D, pg8::EpiBf16{Y, D, 0, 0}, G);
    small_gemm<4, 2, 128, 2>(Ob + (size_t)MLAT * D, (const bf16_t*)(ws + WS_WRO), MCTX, D, lds, vcu, G, DstPlain{Y + (size_t)MLAT * D, D});
    GRID_SYNC();
    { RowArgs r{}; r.xold_lat = a.x; r.xold_ctx = a.ctx; r.xnew_b = XB; r.y = Y; r.u = U; r.gY = ng + 1 * D; r.gU = ng + 2 * D; r.mods = mods; r.modsU = mods; r.gidx = 2; r.sidx = 3; r.nrows = MALL; phase_rows(r, vcu, G); }
    GRID_SYNC();
    run_gemm(lds, U, (const bf16_t*)(ws + WS_WFI0), MALL, 2 * FFH, D, pg8::EpiSwiglu{H, FFH, 0}, G);
    GRID_SYNC();
    run_gemm(lds, H, (const bf16_t*)(ws + WS_WFO0), MLAT, D, FFH, pg8::EpiBf16{Y, D, 0, 0}, G);
    run_gemm_ctx_splitk(lds, H + (size_t)MLAT * FFH, (const bf16_t*)(ws + WS_WFO0), FFH, (bf16_t*)a.out, G);
    GRID_SYNC();
    { RowArgs r{}; r.xold_b = XB; r.xnew_b = XB; r.y = Y; r.yslab = (const bf16_t*)a.out; r.u = U; r.gY = ng + 3 * D; r.gU = ng + 4 * D; r.mods = mods; r.modsU = mods + 17 * 6144; r.gidx = 5; r.sidx = 0; r.nrows = MALL; phase_rows(r, vcu, G); }
    GRID_SYNC();
    bf16_t* Qb = (bf16_t*)(ws + WS_Q); bf16_t* Kb = (bf16_t*)(ws + WS_K); bf16_t* Vb = (bf16_t*)(ws + WS_V); bf16_t* Kc = (bf16_t*)(ws + WS_KC); bf16_t* Vc = (bf16_t*)(ws + WS_VC); bf16_t* Oa = (bf16_t*)(ws + WS_O);
    run_gemm(lds, U, (const bf16_t*)(ws + WS_WQKV), MLAT, 1536, D, pg8::EpiQKV{Qb, Kb, Vb, (const float*)(ws + WS_ROPE)}, G);
    SG_REP small_gemm<4, 2, 256, 1>(U + (size_t)MLAT * D, (const bf16_t*)(ws + WS_WQKV) + (size_t)1024 * D, MCTX, 512, lds, vcu, G, DstKV{Kc, Vc});
    GRID_SYNC();
    attn_phase(Qb, Kb, Vb, Kc, Vc, a.att_sink, Oa, lds, vcu, G);
    GRID_SYNC();
    run_gemm(lds, Oa, (const bf16_t*)(ws + WS_WO), MLAT, D, D, pg8::EpiBf16{Y, D, 0, 0}, G);
    GRID_SYNC();
    { RowArgs r{}; r.xold_b = XB; r.xnew_b = XB; r.y = Y; r.u = U; r.gY = ng + 5 * D; r.gU = ng + 6 * D; r.mods = mods + 17 * 6144; r.modsU = mods + 17 * 6144; r.gidx = 2; r.sidx = 3; r.nrows = MLAT; phase_rows(r, vcu, G); }
    GRID_SYNC();
    run_gemm(lds, U, (const bf16_t*)(ws + WS_WFI1), MLAT, 2 * FFH, D, pg8::EpiSwiglu{H, FFH, 0}, G);
    GRID_SYNC();
    run_gemm(lds, H, (const bf16_t*)(ws + WS_WFO1), MLAT, D, FFH, pg8::EpiBf16{Y, D, 0, 0}, G);
    GRID_SYNC();
    { RowArgs r{}; r.xold_b = XB; r.xnew_lat = out; r.y = Y; r.gY = ng + 7 * D; r.mods = mods + 17 * 6144; r.gidx = 5; r.nrows = MLAT; phase_rows(r, vcu, G); }
}

extern "C" void kernel_launch(void* const* d_in, const int* in_sizes, int n_in, void* d_out, int out_size, void* d_ws, size_t ws_size, hipStream_t stream) {
    static int grid = 0;
    if (grid == 0) {
        if (n_in != 19 || out_size != MLAT * D || ws_size < WS_END) { fprintf(stderr, "kernel_launch: unexpected sizes n_in %d out %d ws %zu\n", n_in, out_size, ws_size); grid = -1; return; }
        int dev = 0, cus = 0, per_cu = 0;
        hipGetDevice(&dev); hipDeviceGetAttribute(&cus, hipDeviceAttributeMultiprocessorCount, dev);
        if (hipFuncSetAttribute((const void*)mega_fwd, hipFuncAttributeMaxDynamicSharedMemorySize, LDS_BYTES) != hipSuccess) { fprintf(stderr, "kernel_launch: hipFuncSetAttribute failed\n"); grid = -1; return; }
        if (hipOccupancyMaxActiveBlocksPerMultiprocessor(&per_cu, (const void*)mega_fwd, NTHREADS, LDS_BYTES) != hipSuccess || per_cu < 1) { fprintf(stderr, "kernel_launch: occupancy query says %d blocks per CU\n", per_cu); grid = -1; return; }
        grid = cus;
        fprintf(stderr, "kernel_launch: %d CUs, occupancy %d per CU, grid %d\n", cus, per_cu, grid);
    }
    if (grid < 0) return;
    Args a{};
    a.x = (const float*)d_in[0]; a.c = (const float*)d_in[1]; a.ctx = (const float*)d_in[2]; a.c_ctx = (const float*)d_in[3]; a.ada_w = (const float*)d_in[4]; a.ada_b = (const float*)d_in[5];
    a.norm_g = (const float*)d_in[6]; a.rec_w_in = (const float*)d_in[7]; a.rec_w_out = (const float*)d_in[8]; a.rec_lb = (const float*)d_in[9]; a.rec_w_g2 = (const float*)d_in[10];
    a.rec_b_g2 = (const float*)d_in[11]; a.gn_a = (const float*)d_in[12]; a.gn_b = (const float*)d_in[13]; a.att_w_qkv = (const float*)d_in[14]; a.att_w_o = (const float*)d_in[15];
    a.att_sink = (const float*)d_in[16]; a.ffn_w_in = (const float*)d_in[17]; a.ffn_w_out = (const float*)d_in[18];
    a.out = (float*)d_out; a.ws = (unsigned char*)d_ws;
    if (hipMemsetAsync((char*)d_ws + WS_BAR, 0, WS_BAR_BYTES, stream) != hipSuccess) { fprintf(stderr, "kernel_launch: memset failed\n"); return; }
    void* args[] = {&a};
    hipError_t e = hipLaunchCooperativeKernel((const void*)mega_fwd, dim3(grid), dim3(NTHREADS), args, LDS_BYTES, stream);
    if (e != hipSuccess) fprintf(stderr, "kernel_launch: cooperative launch failed: %s (grid %d)\n", hipGetErrorString(e), grid);
}
```
